# Optimizing an MI355X kernel written in HIP

```python
import math
import jax, jax.numpy as jnp
from jax import lax
import numpy as np

D_MODEL = 1024
BATCH = 8
SEQ = 2048
DEPTH = 4
DEC_BATCH = 2
DEC_SEQ = 8192
PAST_LEN = 128

N_MIXERS = 3
GRID_W = 64
Q_BLOCK = 128
RMS_EPS = 1e-6
D_FF = 2816

REL_BUCKETS = 32
REL_MAX_DIST = 128
N_BIAS_HEADS = 16

MLA_HEADS = 16
MLA_Q_LORA = 512
MLA_KV_LORA = 256
MLA_NOPE = 64
MLA_ROPE = 32
MLA_V = 64
ROPE_THETA = 10000.0

DIFF_HEADS = 8
DIFF_QK = 64
DIFF_V = 2 * DIFF_QK

NA_HEADS = 16
NA_HEAD_DIM = 64
NA_KR = 8
NA_KC = 16

kernel_name = 'hybrid_mla_diff_natten_macaron_encoder'


def rms_norm(x, g):
    xf = x.astype(jnp.float32)
    y = xf * lax.rsqrt(jnp.mean(xf * xf, axis=-1, keepdims=True) + RMS_EPS)
    return (y * g.astype(jnp.float32)).astype(x.dtype)


def swiglu(h, w_gate, w_up, w_down):
    return (jax.nn.silu(h @ w_gate) * (h @ w_up)) @ w_down


def rope(x, pos):
    half = x.shape[-1] // 2
    freqs = ROPE_THETA ** (-jnp.arange(half, dtype=jnp.float32) / half)
    ang = pos.astype(jnp.float32)[:, None] * freqs[None, :]
    cos = jnp.cos(ang)[:, None, :]
    sin = jnp.sin(ang)[:, None, :]
    x1 = x[..., :half].astype(jnp.float32)
    x2 = x[..., half:].astype(jnp.float32)
    return jnp.concatenate([x1 * cos - x2 * sin, x1 * sin + x2 * cos], axis=-1).astype(x.dtype)


def t5_bucket(rel):
    half = REL_BUCKETS // 2
    max_exact = half // 2
    n = jnp.abs(rel)
    nf = jnp.maximum(n, max_exact).astype(jnp.float32)
    big = max_exact + (jnp.log(nf / max_exact) / math.log(REL_MAX_DIST / max_exact)
                       * (half - max_exact)).astype(jnp.int32)
    big = jnp.minimum(big, half - 1)
    return jnp.where(rel > 0, half, 0) + jnp.where(n < max_exact, n, big)


def t5_bias_block(table, q_start, n_keys):
    qpos = q_start + jnp.arange(Q_BLOCK)
    kpos = jnp.arange(n_keys)
    b = t5_bucket(kpos[None, :] - qpos[:, None])
    return jnp.transpose(table[b], (2, 0, 1)).astype(jnp.float32)


def dense_attention_blocks(q, k, table, mix):
    B, N, Hm, dk = q.shape
    nb = N // Q_BLOCK
    qb = q.reshape(B, nb, Q_BLOCK, Hm, dk).transpose(1, 0, 2, 3, 4)

    def one(args):
        i, q_i = args
        s = jnp.einsum('bqhd,bkhd->bhqk', q_i, k).astype(jnp.float32)
        s = s + t5_bias_block(table, i * Q_BLOCK, N)[None]
        return mix(jax.nn.softmax(s, axis=-1))

    out = lax.map(one, (jnp.arange(nb), qb))
    return out.transpose(1, 0, 2, 3, 4).reshape(B, N, out.shape[-2], out.shape[-1])


def mla_mixer(h, w_dq, g_q, w_uq, w_dkv, g_kv, w_uk, w_uv, w_o, table):
    B, N, _ = h.shape
    pos = jnp.arange(N)
    c_q = rms_norm(h @ w_dq, g_q)
    q = (c_q @ w_uq).reshape(B, N, MLA_HEADS, MLA_NOPE + MLA_ROPE)
    q_rope = rope(q[..., MLA_NOPE:], pos)
    kv = h @ w_dkv
    c_kv = rms_norm(kv[..., :MLA_KV_LORA], g_kv)
    k_rope = rope(kv[..., MLA_KV_LORA:][:, :, None, :], pos)
    k_nope = (c_kv @ w_uk).reshape(B, N, MLA_HEADS, MLA_NOPE)
    v = (c_kv @ w_uv).reshape(B, N, MLA_HEADS, MLA_V)
    scale = (MLA_NOPE + MLA_ROPE) ** -0.5
    qf = jnp.concatenate([q[..., :MLA_NOPE], q_rope], axis=-1) * scale
    kf = jnp.concatenate([k_nope, jnp.broadcast_to(k_rope, (B, N, MLA_HEADS, MLA_ROPE))], axis=-1)

    def mix(p):
        return jnp.einsum('bhqk,bkhd->bqhd', p.astype(v.dtype), v)

    o = dense_attention_blocks(qf, kf, table, mix)
    return o.reshape(B, N, MLA_HEADS * MLA_V) @ w_o


def diff_mixer(h, w_q, w_k, w_v, lam_q1, lam_k1, lam_q2, lam_k2, g_sub, w_o, table, lam_init):
    B, N, _ = h.shape
    q = (h @ w_q).reshape(B, N, 2 * DIFF_HEADS, DIFF_QK) * (DIFF_QK ** -0.5)
    k = (h @ w_k).reshape(B, N, 2 * DIFF_HEADS, DIFF_QK)
    v = (h @ w_v).reshape(B, N, DIFF_HEADS, DIFF_V)
    lam = (jnp.exp(jnp.sum(lam_q1.astype(jnp.float32) * lam_k1.astype(jnp.float32)))
           - jnp.exp(jnp.sum(lam_q2.astype(jnp.float32) * lam_k2.astype(jnp.float32)))
           + lam_init)

    def mix(p):
        p = p.reshape(B, DIFF_HEADS, 2, Q_BLOCK, N)
        a = p[:, :, 0] - lam * p[:, :, 1]
        return jnp.einsum('bhqk,bkhd->bqhd', a.astype(v.dtype), v)

    o = dense_attention_blocks(q, k, table, mix)
    o = rms_norm(o, g_sub) * (1.0 - lam_init)
    return o.reshape(B, N, DIFF_HEADS * DIFF_V) @ w_o


def na_mixer(h, w_qkv, rpb, w_o):
    B, N, _ = h.shape
    rows = N // GRID_W
    kr = min(NA_KR, rows)
    kc = NA_KC
    qkv = (h @ w_qkv).reshape(B, rows, GRID_W, 3, NA_HEADS, NA_HEAD_DIM)
    q = qkv[:, :, :, 0] * (NA_HEAD_DIM ** -0.5)
    k = qkv[:, :, :, 1]
    v = qkv[:, :, :, 2]
    c = jnp.arange(GRID_W)
    col_idx = jnp.clip(c - kc // 2, 0, GRID_W - kc)[:, None] + jnp.arange(kc)[None, :]
    col_off = col_idx - c[:, None] + (NA_KC - 1)
    r = jnp.arange(rows)
    row_start = jnp.clip(r - kr // 2, 0, rows - kr)

    def one(args):
        r_i, rs, q_r = args
        k_blk = lax.dynamic_slice_in_dim(k, rs, kr, axis=1)
        v_blk = lax.dynamic_slice_in_dim(v, rs, kr, axis=1)
        k_g = k_blk[:, :, col_idx]
        v_g = v_blk[:, :, col_idx]
        s = jnp.einsum('bchd,bacehd->bhcae', q_r, k_g).astype(jnp.float32)
        row_off = rs + jnp.arange(kr) - r_i + (NA_KR - 1)
        bias = rpb[:, row_off[:, None, None], col_off[None, :, :]]
        s = s + jnp.transpose(bias, (0, 2, 1, 3)).astype(jnp.float32)[None]
        p = jax.nn.softmax(s.reshape(B, NA_HEADS, GRID_W, kr * kc), axis=-1)
        p = p.reshape(B, NA_HEADS, GRID_W, kr, kc)
        return jnp.einsum('bhcae,bacehd->bchd', p.astype(v.dtype), v_g)

    out = lax.map(one, (r, row_start, q.transpose(1, 0, 2, 3, 4)))
    out = out.transpose(1, 0, 2, 3, 4).reshape(B, N, NA_HEADS * NA_HEAD_DIM)
    return out @ w_o


def trunk(x, norm_g, final_g, ffn_w_gate, ffn_w_up, ffn_w_down, rel_bias_table,
          mla_w_dq, mla_g_q, mla_w_uq, mla_w_dkv, mla_g_kv, mla_w_uk, mla_w_uv, mla_w_o,
          diff_w_q, diff_w_k, diff_w_v, diff_lam_q1, diff_lam_k1, diff_lam_q2, diff_lam_k2,
          diff_g_sub, diff_w_o, na_w_qkv, na_rpb, na_w_o):
    for i in range(DEPTH):
        x = x + 0.5 * swiglu(rms_norm(x, norm_g[i, 0]), ffn_w_gate[i, 0], ffn_w_up[i, 0], ffn_w_down[i, 0])
        hn = rms_norm(x, norm_g[i, 1])
        m, j = i % N_MIXERS, i // N_MIXERS
        if m == 0:
            y = mla_mixer(hn, mla_w_dq[j], mla_g_q[j], mla_w_uq[j], mla_w_dkv[j], mla_g_kv[j],
                          mla_w_uk[j], mla_w_uv[j], mla_w_o[j], rel_bias_table)
        elif m == 1:
            lam_init = 0.8 - 0.6 * math.exp(-0.3 * i)
            y = diff_mixer(hn, diff_w_q[j], diff_w_k[j], diff_w_v[j], diff_lam_q1[j], diff_lam_k1[j],
                           diff_lam_q2[j], diff_lam_k2[j], diff_g_sub[j], diff_w_o[j],
                           rel_bias_table, lam_init)
        else:
            y = na_mixer(hn, na_w_qkv[j], na_rpb[j], na_w_o[j])
        x = x + y
        x = x + 0.5 * swiglu(rms_norm(x, norm_g[i, 2]), ffn_w_gate[i, 1], ffn_w_up[i, 1], ffn_w_down[i, 1])
    return rms_norm(x, final_g)


def setup_inputs(seed: int = 0) -> dict:
    key = jax.random.key(seed)
    ks = iter(jax.random.split(key, 40))
    n_a = len(range(0, DEPTH, N_MIXERS))
    n_b = len(range(1, DEPTH, N_MIXERS))
    n_c = len(range(2, DEPTH, N_MIXERS))
    D = D_MODEL

    def w(shape, fan_in):
        return jax.random.normal(next(ks), shape, jnp.float32) * fan_in ** -0.5

    def gain(shape):
        return 1.0 + 0.05 * jax.random.normal(next(ks), shape, jnp.float32)

    def small(shape, s):
        return s * jax.random.normal(next(ks), shape, jnp.float32)

    return {
        'x_prompt': jax.random.normal(next(ks), (BATCH, SEQ, D), jnp.float32),
        'x_sample': jax.random.normal(next(ks), (DEC_BATCH, DEC_SEQ, D), jnp.float32),
        'norm_g': gain((DEPTH, 3, D)),
        'final_g': gain((D,)),
        'ffn_w_gate': w((DEPTH, 2, D, D_FF), D),
        'ffn_w_up': w((DEPTH, 2, D, D_FF), D),
        'ffn_w_down': w((DEPTH, 2, D_FF, D), D_FF),
        'rel_bias_table': small((REL_BUCKETS, N_BIAS_HEADS), 0.5),
        'mla_w_dq': w((n_a, D, MLA_Q_LORA), D),
        'mla_g_q': gain((n_a, MLA_Q_LORA)),
        'mla_w_uq': w((n_a, MLA_Q_LORA, MLA_HEADS * (MLA_NOPE + MLA_ROPE)), MLA_Q_LORA),
        'mla_w_dkv': w((n_a, D, MLA_KV_LORA + MLA_ROPE), D),
        'mla_g_kv': gain((n_a, MLA_KV_LORA)),
        'mla_w_uk': w((n_a, MLA_KV_LORA, MLA_HEADS * MLA_NOPE), MLA_KV_LORA),
        'mla_w_uv': w((n_a, MLA_KV_LORA, MLA_HEADS * MLA_V), MLA_KV_LORA),
        'mla_w_o': w((n_a, MLA_HEADS * MLA_V, D), MLA_HEADS * MLA_V),
        'diff_w_q': w((n_b, D, 2 * DIFF_HEADS * DIFF_QK), D),
        'diff_w_k': w((n_b, D, 2 * DIFF_HEADS * DIFF_QK), D),
        'diff_w_v': w((n_b, D, DIFF_HEADS * DIFF_V), D),
        'diff_lam_q1': small((n_b, DIFF_QK), 0.1),
        'diff_lam_k1': small((n_b, DIFF_QK), 0.1),
        'diff_lam_q2': small((n_b, DIFF_QK), 0.1),
        'diff_lam_k2': small((n_b, DIFF_QK), 0.1),
        'diff_g_sub': gain((n_b, DIFF_V)),
        'diff_w_o': w((n_b, DIFF_HEADS * DIFF_V, D), DIFF_HEADS * DIFF_V),
        'na_w_qkv': w((n_c, D, 3 * NA_HEADS * NA_HEAD_DIM), D),
        'na_rpb': small((n_c, NA_HEADS, 2 * NA_KR - 1, 2 * NA_KC - 1), 0.2),
        'na_w_o': w((n_c, NA_HEADS * NA_HEAD_DIM, D), NA_HEADS * NA_HEAD_DIM),
    }


def reference(x_prompt, x_sample, norm_g, final_g, ffn_w_gate, ffn_w_up, ffn_w_down, rel_bias_table,
              mla_w_dq, mla_g_q, mla_w_uq, mla_w_dkv, mla_g_kv, mla_w_uk, mla_w_uv, mla_w_o,
              diff_w_q, diff_w_k, diff_w_v, diff_lam_q1, diff_lam_k1, diff_lam_q2, diff_lam_k2,
              diff_g_sub, diff_w_o, na_w_qkv, na_rpb, na_w_o):
    y_prompt = trunk(x_prompt, norm_g, final_g, ffn_w_gate, ffn_w_up, ffn_w_down, rel_bias_table,
                     mla_w_dq, mla_g_q, mla_w_uq, mla_w_dkv, mla_g_kv, mla_w_uk, mla_w_uv, mla_w_o,
                     diff_w_q, diff_w_k, diff_w_v, diff_lam_q1, diff_lam_k1, diff_lam_q2, diff_lam_k2,
                     diff_g_sub, diff_w_o, na_w_qkv, na_rpb, na_w_o)
    y_sample = trunk(x_sample, norm_g, final_g, ffn_w_gate, ffn_w_up, ffn_w_down, rel_bias_table,
                     mla_w_dq, mla_g_q, mla_w_uq, mla_w_dkv, mla_g_kv, mla_w_uk, mla_w_uv, mla_w_o,
                     diff_w_q, diff_w_k, diff_w_v, diff_lam_q1, diff_lam_k1, diff_lam_q2, diff_lam_k2,
                     diff_g_sub, diff_w_o, na_w_qkv, na_rpb, na_w_o)
    return (y_prompt, y_sample)
```

```cpp
#include <hip/hip_runtime.h>
#include <hip/hip_cooperative_groups.h>
#include <cstdio>
#include <cstdint>
#include <cmath>
namespace cg = cooperative_groups;

#define LAS __attribute__((address_space(3)))
#define DI __device__ __forceinline__
typedef unsigned short bf16_t;
typedef short bf16x8 __attribute__((ext_vector_type(8)));
typedef short s16x4 __attribute__((ext_vector_type(4)));
typedef float f32x4 __attribute__((ext_vector_type(4)));
typedef float f32x16 __attribute__((ext_vector_type(16)));
typedef unsigned u32x4 __attribute__((ext_vector_type(4)));
typedef unsigned u32x2 __attribute__((ext_vector_type(2)));

constexpr int T = 32768, DM = 1024, FF = 2816;
constexpr float LOG2E = 1.4426950408889634f;
constexpr float EPS = 1e-6f;
constexpr size_t MiB = 1024ull * 1024ull;
constexpr size_t OFF_A = 0;
constexpr size_t OFF_BIG = 64 * MiB;
constexpr size_t OFF_W = 320 * MiB;
constexpr size_t OFF_MISC = 368 * MiB;
constexpr size_t OFF_P4 = OFF_MISC;
constexpr size_t OFF_PQ = OFF_P4 + 4ull * T * 4;
constexpr size_t OFF_PKV = OFF_PQ + 2ull * T * 4;
constexpr size_t OFF_ROPE = OFF_PKV + 1ull * T * 4;
constexpr size_t OFF_XBAR = OFF_MISC + 2 * MiB;
constexpr size_t OFF_XR = OFF_MISC + 3 * MiB;
constexpr size_t WS_END = OFF_XR + 64 * MiB;
constexpr size_t W_GU0 = 0, W_GU_SZ = 5632ull * 1024 * 2, W_DN_SZ = 1024ull * 2816 * 2;
constexpr size_t W_DN0 = W_GU0 + W_GU_SZ, W_GU1 = W_DN0 + W_DN_SZ, W_DN1 = W_GU1 + W_GU_SZ, W_MIX = W_DN1 + W_DN_SZ;

enum { OP_END = 0, OP_CONV, OP_FFN_UP, OP_FFN_DOWN, OP_MLA_C, OP_MLA_Q, OP_MLA_KV, OP_ATT_MLA, OP_WO, OP_QKV, OP_ATT_DIFF, OP_ATT_NA, OP_FINAL };
enum { EPI_FFN_UP = 0, EPI_RESID, EPI_MLA_C, EPI_MLA_Q, EPI_KV };

struct Params {
  const float* in[28];
  float* out;
  unsigned char* ws;
  unsigned* bar;
};
typedef const __attribute__((address_space(4))) Params* KP;
#define OPC(kind, layer, sub, sync) (unsigned char)((kind) | ((layer) << 4) | ((sub) << 6) | ((sync) << 7))
#define LAYER_HEAD(l) OPC(OP_CONV, l, 0, 1), OPC(OP_FFN_UP, l, 0, 1), OPC(OP_FFN_DOWN, l, 0, 1)
#define LAYER_TAIL(l) OPC(OP_WO, l, 0, 1), OPC(OP_FFN_UP, l, 1, 1), OPC(OP_FFN_DOWN, l, 1, 1)
#define LAYER_MLA(l) LAYER_HEAD(l), OPC(OP_MLA_C, l, 0, 1), OPC(OP_MLA_Q, l, 0, 0), OPC(OP_MLA_KV, l, 0, 1), OPC(OP_ATT_MLA, l, 0, 1), LAYER_TAIL(l)
__device__ const unsigned char PROG[48] = {
  LAYER_MLA(0),
  LAYER_HEAD(1), OPC(OP_QKV, 1, 0, 1), OPC(OP_ATT_DIFF, 1, 0, 1), LAYER_TAIL(1),
  LAYER_HEAD(2), OPC(OP_QKV, 2, 0, 1), OPC(OP_ATT_NA, 2, 0, 1), LAYER_TAIL(2),
  LAYER_MLA(3),
  OPC(OP_FINAL, 0, 0, 0), OPC(OP_END, 0, 0, 0) };
__device__ const float FREQ[16] = {1.000000000e+00f, 5.623413324e-01f, 3.162277639e-01f, 1.778279394e-01f, 1.000000015e-01f, 5.623413250e-02f, 3.162277490e-02f, 1.778279431e-02f,
  9.999999776e-03f, 5.623413250e-03f, 3.162277630e-03f, 1.778279431e-03f, 1.000000047e-03f, 5.623413017e-04f, 3.162277571e-04f, 1.778279402e-04f};

DI unsigned cvt_pk(float lo, float hi) { unsigned r; asm volatile("v_cvt_pk_bf16_f32 %0, %1, %2" : "=v"(r) : "v"(lo), "v"(hi)); return r; }
DI u32x2 pk4(f32x4 v) { u32x2 r; r.x = cvt_pk(v[0], v[1]); r.y = cvt_pk(v[2], v[3]); return r; }
DI int opaque_tid() { int t = threadIdx.x; asm volatile("" : "+v"(t)); return t; }
DI float fexp2(float x) { return __builtin_amdgcn_exp2f(x); }
DI float frcp(float x) { return __builtin_amdgcn_rcpf(x); }
DI void tok_info(int t, int& tb, int& L, int& pos) {
  if (t < 16384) { L = 2048; tb = t & ~2047; pos = t & 2047; }
  else { L = 8192; const int u = t - 16384; tb = 16384 + (u & ~8191); pos = u & 8191; }
}

constexpr int BK = 64, HTB = 128 * BK * 2;
DI int lds_byte(int r, int c) { const int st = (r >> 4) * 2 + (c >> 5), rr = r & 15, cc = c & 31, ob = rr * 64 + cc * 2; return st * 1024 + (ob ^ (((ob >> 9) & 1) << 5)); }
DI void stage_rc(int b, int& R, int& C) { const int st = b / 1024, sb = b % 1024, swz = sb ^ (((sb >> 9) & 1) << 5); R = (st >> 1) * 16 + swz / 64; C = (st & 1) * 32 + (swz % 64) / 2; }

DI int perm32(int rho) { const int n = rho >> 4, i = rho & 15; return 8 * (i >> 2) + 4 * n + (i & 3); }
struct GemmDesc {
  const bf16_t* A; int lda; const bf16_t* B; int ldb; int K, nM, nN, epi, vpn;
  const float* P; int np; float inv_dim;
  bf16_t* O0; bf16_t* O1; bf16_t* O2; float* Pout; float* Pout2;
  const float* rope; int kmode; int perm; int ablk; int pn0, nNs, swp;
};

DI float row_rstd(const float* P, int np, float inv_dim, int row) {
  float s = P[row];
  if (np > 1) s += P[T + row];
  if (np > 2) s += P[2 * T + row] + P[3 * T + row];
  return rsqrtf(s * inv_dim + EPS);
}

#ifdef ONLY_EPI
#define EPI_ON(x) ((x) == ONLY_EPI && d.epi == (x))
#else
#define EPI_ON(x) (d.epi == (x))
#endif

#define G_LBAR do { asm volatile("s_waitcnt lgkmcnt(0)" ::: "memory"); __builtin_amdgcn_s_barrier(); asm volatile("" ::: "memory"); } while (0)
DI void gemm_phase(LAS unsigned char* lds, const GemmDesc& d, float* __restrict__ X) {
  const int nwg = d.nM * d.nNs, G = gridDim.x, c = blockIdx.x;
  const bool sw = d.swp != 0;
  auto tile_of = [&](int it, int& pm, int& pn) __attribute__((always_inline)) -> bool {
    const long Lx = (long)it * G + c; if (Lx >= nwg) return false;
    int wgid = (int)Lx; { const int q = nwg / 8, r = nwg % 8, xcd = wgid % 8, off = wgid / 8; wgid = (xcd < r ? xcd * (q + 1) : r * (q + 1) + (xcd - r) * q) + off; }
    const int nig = 8 * d.nNs, gid = wgid / nig, fm = gid * 8, gsz = (d.nM - fm) < 8 ? (d.nM - fm) : 8;
    pm = fm + ((wgid % nig) % gsz); pn = d.pn0 + (wgid % nig) / gsz; return true; };
  const int la = d.ablk ? 64 : (sw ? d.ldb : d.lda), lb = sw ? d.lda : d.ldb;
  const size_t kstepA = d.ablk ? (size_t)(256 * 64 * 2) : (size_t)128, kstepB = 128;
  const size_t hstepA = (size_t)256 * la, hstepB = (size_t)256 * lb;
  auto opA = [&](int pm, int pn) __attribute__((always_inline)) -> const char* { return (const char*)(sw ? d.B + (size_t)pn * 256 * d.ldb : d.A + (size_t)pm * 256 * d.lda); };
  auto opB = [&](int pm, int pn) __attribute__((always_inline)) -> const char* { return (const char*)(sw ? d.A + (size_t)pm * 256 * d.lda : d.B + (size_t)pn * 256 * d.ldb); };
  __syncthreads();
  int pm, pn; if (!tile_of(0, pm, pn)) return;
  const int ktid = opaque_tid(), kwid = __builtin_amdgcn_readfirstlane(ktid >> 6), klane = ktid & 63, kwr = kwid >> 2, kwc = kwid & 3, kfr = klane & 15, kfq = klane >> 4;
  unsigned voffA[2], voffB[2];
#pragma unroll
  for (int i = 0; i < 2; ++i) { int R, C; stage_rc(ktid * 16 + i * 8192, R, C); const int Rb = d.perm ? ((R & ~31) + perm32(R & 31)) : R; voffA[i] = (unsigned)(R * la + C) * 2u; voffB[i] = (unsigned)(Rb * lb + C) * 2u; }
  const unsigned ldsw = (unsigned)kwid * 1024u;
  const int aoff = lds_byte(kwr * 64 + kfr, kfq * 8), boff = lds_byte(kwc * 32 + kfr, kfq * 8);
  const int nt = d.K / BK;
#define S_SA(b, h) (((b) * 2 + (h)) * HTB)
#define S_SB(b, h) ((4 + (b) * 2 + (h)) * HTB)
#define S_STAGE(bufoff, gbase, voff) do { _Pragma("unroll") for (int _i = 0; _i < 2; ++_i) \
    __builtin_amdgcn_global_load_lds((const unsigned*)((gbase) + (voff)[_i]), (LAS unsigned*)(lds + (bufoff) + ldsw + _i * 8192), 16, 0, 0); } while (0)
#define S_LDA(dst, b, h) do { _Pragma("unroll") for (int m = 0; m < 4; ++m) _Pragma("unroll") for (int k = 0; k < 2; ++k) dst[m][k] = *(const LAS bf16x8*)(lds + S_SA(b, h) + aoff + m * 2048 + k * 1024); } while (0)
#define S_LDB(dst, b, h) do { _Pragma("unroll") for (int n = 0; n < 2; ++n) _Pragma("unroll") for (int k = 0; k < 2; ++k) dst[n][k] = *(const LAS bf16x8*)(lds + S_SB(b, h) + boff + n * 2048 + k * 1024); } while (0)
#define S_MMA(ai, bj, At_, Bt_) do { __builtin_amdgcn_s_setprio(1); _Pragma("unroll") for (int m = 0; m < 4; ++m) _Pragma("unroll") for (int n = 0; n < 2; ++n) _Pragma("unroll") for (int k = 0; k < 2; ++k) \
    acc[ai][bj][m][n] = __builtin_amdgcn_mfma_f32_16x16x32_bf16(Bt_[n][k], At_[m][k], acc[ai][bj][m][n], 0, 0, 0); __builtin_amdgcn_s_setprio(0); } while (0)
#define S_WAIT_V(n) asm volatile("s_waitcnt vmcnt(" #n ")" ::: "memory")
#define S_WAIT_L(n) asm volatile("s_waitcnt lgkmcnt(" #n ")" ::: "memory")
#define S_BAR __builtin_amdgcn_s_barrier()
#define S_SCHED __builtin_amdgcn_sched_barrier(0)
  f32x4 acc[2][2][4][2];
#pragma unroll
  for (int a = 0; a < 2; ++a)
#pragma unroll
    for (int b = 0; b < 2; ++b)
#pragma unroll
      for (int m = 0; m < 4; ++m)
#pragma unroll
        for (int n = 0; n < 2; ++n) acc[a][b][m][n] = (f32x4){0.f, 0.f, 0.f, 0.f};
  bf16x8 At[4][2], B0[2][2], B1[2][2];
  const char* cA = opA(pm, pn); const char* cB = opB(pm, pn);
  S_STAGE(S_SB(0, 0), cB, voffB); S_STAGE(S_SB(0, 1), cB + hstepB, voffB); S_STAGE(S_SA(0, 0), cA, voffA); S_STAGE(S_SA(0, 1), cA + hstepA, voffA);
  if (kwr == 1) S_BAR;
  S_WAIT_V(2); S_BAR;
  S_STAGE(S_SB(1, 0), cB + kstepB, voffB); S_STAGE(S_SA(1, 0), cA + kstepA, voffA); S_STAGE(S_SB(1, 1), cB + hstepB + kstepB, voffB);
  S_WAIT_V(6); S_BAR;
  for (int ui = 0;; ++ui) {
    int pm2 = 0, pn2 = 0; const bool has_next = tile_of(ui + 1, pm2, pn2);
    const char* nA = has_next ? opA(pm2, pn2) : cA; const char* nB = has_next ? opB(pm2, pn2) : cB;
    LAS float* rsl = (LAS float*)(lds + 131072 + (ui & 1) * 1024);
    if (ui == 0 && d.epi != EPI_RESID) { if (ktid < 256) rsl[ktid] = row_rstd(d.P, d.np, d.inv_dim, pm * 256 + ktid); }
    for (int t = 0; t < nt; t += 2) {
      const bool last = (t == nt - 2);
      const char* a1 = cA + (size_t)(t + 1) * kstepA;
      const char* a2 = last ? nA : cA + (size_t)(t + 2) * kstepA; const char* b2 = last ? nB : cB + (size_t)(t + 2) * kstepB;
      const char* a3 = a2 + kstepA; const char* b3 = b2 + kstepB;
      S_LDB(B0, 0, 0); S_LDB(B1, 0, 1); S_SCHED; S_LDA(At, 0, 0); S_STAGE(S_SA(1, 1), a1 + hstepA, voffA);
      S_WAIT_V(8); S_WAIT_L(0); S_BAR; S_MMA(0, 0, At, B0); S_MMA(0, 1, At, B1); S_BAR; S_SCHED;
      S_LDA(At, 0, 1); S_STAGE(S_SB(0, 0), b2, voffB); S_STAGE(S_SB(0, 1), b2 + hstepB, voffB); S_STAGE(S_SA(0, 0), a2, voffA);
      S_WAIT_V(8); S_WAIT_L(0); S_BAR; S_MMA(1, 0, At, B0); S_MMA(1, 1, At, B1); S_BAR; S_SCHED;
      S_LDB(B0, 1, 0); S_LDB(B1, 1, 1); S_SCHED; S_LDA(At, 1, 0); S_STAGE(S_SA(0, 1), a2 + hstepA, voffA);
      S_WAIT_V(8); S_WAIT_L(0); S_BAR; S_MMA(0, 0, At, B0); S_MMA(0, 1, At, B1); S_BAR; S_SCHED;
      S_LDA(At, 1, 1); S_STAGE(S_SB(1, 0), b3, voffB); S_STAGE(S_SB(1, 1), b3 + hstepB, voffB); S_STAGE(S_SA(1, 0), a3, voffA);
      S_WAIT_V(8); S_WAIT_L(0); S_BAR; S_MMA(1, 0, At, B0); S_MMA(1, 1, At, B1); S_BAR; S_SCHED;
    }
    if (kwr == 0) S_BAR;
    const bool nrs = has_next && d.epi != EPI_RESID && ktid < 256;
    float q0 = 0.f, q1 = 0.f, q2 = 0.f, q3 = 0.f;
    if (nrs) { const float* pp = d.P + pm2 * 256 + ktid; q0 = pp[0]; if (d.np > 1) q1 = pp[T]; if (d.np > 2) { q2 = pp[2 * T]; q3 = pp[3 * T]; } }
    {
    const int tid = opaque_tid();
    const int wid = __builtin_amdgcn_readfirstlane(tid >> 6), lane = tid & 63, wr = wid >> 2, wc = wid & 3, fr = lane & 15, fq = lane >> 4;
    const int rb = 64 * wr + fr, cb = d.perm ? 32 * wc + 8 * fq : 32 * wc + 4 * fq, ns = d.perm ? 4 : 16;
    if (EPI_ON(EPI_FFN_UP)) {
#pragma unroll
      for (int ai = 0; ai < 2; ++ai)
#pragma unroll
        for (int m = 0; m < 4; ++m) {
          const int row = pm * 256 + 128 * ai + 16 * m + rb; const float rs = rsl[128 * ai + 16 * m + rb]; const float c1 = -rs * LOG2E, c2 = rs * rs;
          u32x2 hp[2];
#pragma unroll
          for (int n = 0; n < 2; ++n) {
            const f32x4 G = acc[ai][0][m][n], U = acc[ai][1][m][n]; const f32x4 tt = G * c1; f32x4 ee;
#pragma unroll
            for (int j = 0; j < 4; ++j) ee[j] = fexp2(tt[j]);
            const f32x4 dn = ee + 1.f; f32x4 rr;
#pragma unroll
            for (int j = 0; j < 4; ++j) rr[j] = frcp(dn[j]);
            hp[n] = pk4((G * U) * (rr * c2));
          }
          { const int hc = pn * 128 + cb;
            u32x4 hw; hw.x = hp[0].x; hw.y = hp[0].y; hw.z = hp[1].x; hw.w = hp[1].y;
            *(u32x4*)(d.O0 + (size_t)(row >> 8) * (256 * FF) + (size_t)(hc >> 6) * (256 * 64) + (row & 255) * 64 + (hc & 63)) = hw; }
          asm volatile("" ::: "memory");
        }
    } else if (EPI_ON(EPI_RESID)) {
      LAS float* red = (LAS float*)(lds + 133120); const float alpha = d.K == FF ? 0.5f : 1.f;
#pragma unroll
      for (int ai = 0; ai < 2; ++ai)
#pragma unroll
        for (int m = 0; m < 4; ++m) {
          const int row = pm * 256 + 128 * ai + 16 * m + rb; float ss = 0.f;
#pragma unroll
          for (int bj = 0; bj < 2; ++bj) {
            const size_t o = (size_t)row * DM + pn * 256 + 128 * bj + cb;
            const u32x4 xw = *(const u32x4*)(d.O0 + o); u32x4 ow;
#pragma unroll
            for (int n = 0; n < 2; ++n) {
              const unsigned w0 = n ? xw.z : xw.x, w1 = n ? xw.w : xw.y;
              f32x4 xo; xo[0] = __uint_as_float(w0 << 16); xo[1] = __uint_as_float(w0 & 0xffff0000u); xo[2] = __uint_as_float(w1 << 16); xo[3] = __uint_as_float(w1 & 0xffff0000u);
              const f32x4 xn = xo + acc[ai][bj][m][n] * alpha;
              ss += (xn[0] * xn[0] + xn[1] * xn[1]) + (xn[2] * xn[2] + xn[3] * xn[3]);
              const u32x2 pw = pk4(xn); if (n) { ow.z = pw.x; ow.w = pw.y; } else { ow.x = pw.x; ow.y = pw.y; }
            }
            *(u32x4*)(d.O0 + o) = ow;
          }
          ss += __shfl_xor(ss, 16); ss += __shfl_xor(ss, 32);
          if (fq == 0) red[wc * 256 + 128 * ai + 16 * m + rb] = ss;
          asm volatile("" ::: "memory");
        }
      G_LBAR;
      if (tid < 256) d.Pout[(size_t)pn * T + pm * 256 + tid] = (red[tid] + red[256 + tid]) + (red[512 + tid] + red[768 + tid]);
      G_LBAR;
    } else if (EPI_ON(EPI_MLA_C)) {
      if (pn < 3) {
        LAS float* red = (LAS float*)(lds + 133120);
#pragma unroll
        for (int ai = 0; ai < 2; ++ai)
#pragma unroll
          for (int m = 0; m < 4; ++m) {
            const int row = pm * 256 + 128 * ai + 16 * m + rb; const float rs = rsl[128 * ai + 16 * m + rb]; float ss = 0.f;
#pragma unroll
            for (int bj = 0; bj < 2; ++bj) {
              const f32x4 v0 = acc[ai][bj][m][0] * rs, v1 = acc[ai][bj][m][1] * rs;
              ss += ((v0[0] * v0[0] + v0[1] * v0[1]) + (v0[2] * v0[2] + v0[3] * v0[3])) + ((v1[0] * v1[0] + v1[1] * v1[1]) + (v1[2] * v1[2] + v1[3] * v1[3]));
              const u32x2 w0 = pk4(v0), w1 = pk4(v1); u32x4 ww; ww.x = w0.x; ww.y = w0.y; ww.z = w1.x; ww.w = w1.y;
              *(u32x4*)(d.O0 + (size_t)row * DM + pn * 256 + 128 * bj + cb) = ww;
            }
            ss += __shfl_xor(ss, 16); ss += __shfl_xor(ss, 32);
            if (fq == 0) red[wc * 256 + 128 * ai + 16 * m + rb] = ss;
            asm volatile("" ::: "memory");
          }
        G_LBAR;
        float* dst = pn < 2 ? d.Pout + (size_t)pn * T : d.Pout2;
        if (tid < 256) dst[pm * 256 + tid] = (red[tid] + red[256 + tid]) + (red[512 + tid] + red[768 + tid]);
        G_LBAR;
      } else if (wc == 0) {
#pragma unroll
        for (int ai = 0; ai < 2; ++ai)
#pragma unroll
          for (int m = 0; m < 4; ++m) {
            const int row = pm * 256 + 128 * ai + 16 * m + rb; const float rs = rsl[128 * ai + 16 * m + rb];
            int tb, L, pos; tok_info(row, tb, L, pos);
            const f32x4 cs = *(const f32x4*)(d.rope + pos * 16 + 4 * fq), sn = *(const f32x4*)(d.rope + 8192 * 16 + pos * 16 + 4 * fq);
            const f32x4 x1 = acc[ai][0][m][0] * rs, x2 = acc[ai][0][m][1] * rs;
            const u32x2 r1 = pk4(x1 * cs - x2 * sn), r2 = pk4(x1 * sn + x2 * cs);
            bf16_t* kp = d.O1 + (size_t)row * 1536 + 64 + 4 * fq;
#pragma unroll
            for (int hd = 0; hd < 16; ++hd) { *(u32x2*)(kp + hd * 96) = r1; *(u32x2*)(kp + hd * 96 + 16) = r2; }
            asm volatile("" ::: "memory");
          }
      }
    } else if (EPI_ON(EPI_MLA_Q)) {
#pragma unroll
      for (int ai = 0; ai < 2; ++ai)
#pragma unroll
        for (int m = 0; m < 4; ++m) {
          const int row = pm * 256 + 128 * ai + 16 * m + rb; const float rs = rsl[128 * ai + 16 * m + rb];
          int tb, L, pos; tok_info(row, tb, L, pos);
          const f32x4 cs = *(const f32x4*)(d.rope + pos * 16 + 4 * fq), sn = *(const f32x4*)(d.rope + 8192 * 16 + pos * 16 + 4 * fq);
#pragma unroll
          for (int bj = 0; bj < 2; ++bj) {
            const int g32 = pn * 8 + 4 * bj + wc;
            f32x4 v0 = acc[ai][bj][m][0] * rs, v1 = acc[ai][bj][m][1] * rs;
            bf16_t* gp = d.O0 + (size_t)row * 1536 + pn * 256 + 128 * bj + 32 * wc;
            if (g32 % 3 == 2) {
              const f32x4 t0 = v0 * cs - v1 * sn, t1 = v0 * sn + v1 * cs;
              *(u32x2*)(gp + 4 * fq) = pk4(t0); *(u32x2*)(gp + 16 + 4 * fq) = pk4(t1);
            } else {
              const u32x2 w0 = pk4(v0), w1 = pk4(v1); u32x4 ww; ww.x = w0.x; ww.y = w0.y; ww.z = w1.x; ww.w = w1.y; *(u32x4*)(gp + 8 * fq) = ww;
            }
          }
          asm volatile("" ::: "memory");
        }
    } else if (EPI_ON(EPI_KV)) {
      if (!sw) {
#pragma unroll
        for (int ai = 0; ai < 2; ++ai)
#pragma unroll
          for (int m = 0; m < 4; ++m) {
            const int row = pm * 256 + 128 * ai + 16 * m + rb; const float rs = rsl[128 * ai + 16 * m + rb];
#pragma unroll
            for (int bj = 0; bj < 2; ++bj) {
              const int col = pn * 256 + 128 * bj + cb;
              bf16_t* dst;
              if (d.kmode == 0) dst = d.O0 + (size_t)row * 1536 + (col >> 6) * 96 + (col & 63);
              else dst = (pn < 4 ? d.O0 : d.O1) + (size_t)row * DM + (col & 1023);
              const u32x2 w0 = pk4(acc[ai][bj][m][0] * rs), w1 = pk4(acc[ai][bj][m][1] * rs);
              u32x4 ww; ww.x = w0.x; ww.y = w0.y; ww.z = w1.x; ww.w = w1.y; *(u32x4*)dst = ww;
            }
            asm volatile("" ::: "memory");
          }
      } else {
        int tb, L, pos; tok_info(pm * 256, tb, L, pos);
        f32x4 rs4[2][2];
#pragma unroll
        for (int bj = 0; bj < 2; ++bj)
#pragma unroll
          for (int n = 0; n < 2; ++n)
#pragma unroll
            for (int j = 0; j < 4; ++j) rs4[bj][n][j] = rsl[128 * bj + ns * n + cb + j];
#pragma unroll
        for (int ai = 0; ai < 2; ++ai)
#pragma unroll
          for (int m = 0; m < 4; ++m) {
            const int wcol = (pn - d.vpn) * 256 + 128 * ai + 16 * m + rb;
            bf16_t* vp = d.O2 + (size_t)tb * DM + (size_t)wcol * L;
#pragma unroll
            for (int bj = 0; bj < 2; ++bj) {
              const u32x2 w0 = pk4(acc[ai][bj][m][0] * rs4[bj][0]), w1 = pk4(acc[ai][bj][m][1] * rs4[bj][1]);
              u32x4 ww; ww.x = w0.x; ww.y = w0.y; ww.z = w1.x; ww.w = w1.y; *(u32x4*)(vp + ((pos + 128 * bj + cb + 64 * wcol) & (L - 1))) = ww;
            }
            asm volatile("" ::: "memory");
          }
      }
    }
    }
    if (nrs) ((LAS float*)(lds + 131072 + ((ui + 1) & 1) * 1024))[ktid] = rsqrtf(((q0 + q1) + (q2 + q3)) * d.inv_dim + EPS);
    if (!has_next) break;
#pragma unroll
    for (int a = 0; a < 2; ++a)
#pragma unroll
      for (int b = 0; b < 2; ++b)
#pragma unroll
        for (int m = 0; m < 4; ++m)
#pragma unroll
          for (int n = 0; n < 2; ++n) acc[a][b][m][n] = (f32x4){0.f, 0.f, 0.f, 0.f};
    pm = pm2; pn = pn2; cA = nA; cB = nB;
    if (kwr == 1) S_BAR;
  }
  S_WAIT_V(0);
  S_BAR;
#undef S_SA
#undef S_SB
#undef S_STAGE
#undef S_LDA
#undef S_LDB
#undef S_MMA
#undef S_WAIT_V
#undef S_WAIT_L
#undef S_BAR
#undef S_SCHED
}

DI void conv_block(const float* src, int ld, int scol0, bf16_t* dst, int K, int drow0, int k0, const float* gain, float scale, LAS float* scr, int lane, bool rperm = false) {
  if (src) {
    const int l31 = lane & 31, scl = rperm ? (((l31 >> 3) << 2) + (l31 & 3) + (((l31 >> 2) & 1) << 4)) : l31;
    float tmp[32];
#pragma unroll
    for (int i = 0; i < 32; ++i) { const int kk = 2 * i + (lane >> 5); tmp[i] = __builtin_nontemporal_load(src + (size_t)(k0 + kk) * ld + scol0 + scl); }
#pragma unroll
    for (int i = 0; i < 32; ++i) { const int kk = 2 * i + (lane >> 5); scr[kk * 33 + (lane & 31)] = tmp[i]; }
  } else {
#pragma unroll 8
    for (int i = 0; i < 32; ++i) { const int kk = 2 * i + (lane >> 5); scr[kk * 33 + (lane & 31)] = 0.f; }
  }
  asm volatile("s_waitcnt vmcnt(0) lgkmcnt(0)" ::: "memory"); __builtin_amdgcn_wave_barrier();
  const int c = lane & 7;
  float g[8];
#pragma unroll
  for (int e = 0; e < 8; ++e) g[e] = (gain ? gain[k0 + 8 * c + e] : 1.f) * scale;
#pragma unroll
  for (int j = 0; j < 4; ++j) {
    const int n = (lane >> 3) + 8 * j; const LAS float* s = scr + (8 * c) * 33 + n;
    u32x4 o; o.x = cvt_pk(s[0] * g[0], s[33] * g[1]); o.y = cvt_pk(s[66] * g[2], s[99] * g[3]); o.z = cvt_pk(s[132] * g[4], s[165] * g[5]); o.w = cvt_pk(s[198] * g[6], s[231] * g[7]);
    *(u32x4*)(dst + (size_t)(drow0 + n) * K + k0 + 8 * c) = o;
  }
  asm volatile("s_waitcnt lgkmcnt(0)" ::: "memory"); __builtin_amdgcn_wave_barrier();
}
DI void conv_job(const float* src, int ld, int scol0, bf16_t* dst, int K, int drow0, int nrows, const float* gain, float scale, LAS float* scr, int gw, int ngw, int lane, int rmode = 0) {
  const int nkb = K / 64, nblk = nrows / 32, items = nkb * nblk;
  for (int it = gw; it < items; it += ngw) { const int nb = it / nkb, kb = it % nkb; const bool rp = rmode == 1 ? (nb % 3 == 2) : (rmode == 2 ? nb == nblk - 1 : false);
    conv_block(src, ld, scol0 + 32 * nb, dst, K, drow0 + 32 * nb, 64 * kb, gain, scale, scr, lane, rp); }
}
DI void conv_gu(const float* wg, const float* wu, bf16_t* dst, const float* gain, LAS float* scr, int gw, int ngw, int lane) {
  const int nkb = 16, items = nkb * (5632 / 32);
  for (int it = gw; it < items; it += ngw) {
    const int nb = it / nkb, kb = it % nkb, row0 = 32 * nb, pn = row0 >> 8, wi = row0 & 255;
    const float* src = wi < 128 ? wg : wu; const int scol = pn * 128 + (wi & 127);
    conv_block(src, FF, scol, dst, 1024, row0, 64 * kb, gain, 1.f, scr, lane);
  }
}

DI void sincos_f(float a, float& s, float& c) {
  const float kq = rintf(a * 0.636619772f);
  float y = fmaf(-kq, 1.57079637e+00f, a); y = fmaf(-kq, -4.37113883e-08f, y);
  const float y2 = y * y;
  const float sp = y + y * y2 * (-1.66666667e-01f + y2 * (8.33333333e-03f + y2 * (-1.98412698e-04f + y2 * 2.75573192e-06f)));
  const float cp = 1.f + y2 * (-0.5f + y2 * (4.16666667e-02f + y2 * (-1.38888889e-03f + y2 * (2.48015873e-05f + y2 * -2.75573192e-07f))));
  const int q = ((int)kq) & 3;
  float ss = (q & 1) ? cp : sp, cc = (q & 1) ? sp : cp;
  if (q == 1) cc = -cc; else if (q == 2) { ss = -ss; cc = -cc; } else if (q == 3) ss = -ss;
  s = ss; c = cc;
}

struct ConvItem { const float* src; int ld; int scol; bf16_t* dst; int K; int drow; int k0; const float* gain; float scale; bool rp; };
DI void conv_load(const ConvItem& c, int lane, float (&tmp)[32], f32x4 (&g)[2]) {
  const int l31 = lane & 31, scl = c.rp ? (((l31 >> 3) << 2) + (l31 & 3) + (((l31 >> 2) & 1) << 4)) : l31;
  if (c.src) {
#pragma unroll
    for (int i = 0; i < 32; ++i) { const int kk = 2 * i + (lane >> 5); tmp[i] = __builtin_nontemporal_load(c.src + (size_t)(c.k0 + kk) * c.ld + c.scol + scl); }
  } else {
#pragma unroll
    for (int i = 0; i < 32; ++i) tmp[i] = 0.f;
  }
  if (c.gain) { const f32x4* gp = (const f32x4*)(c.gain + c.k0 + 8 * (lane & 7)); g[0] = gp[0]; g[1] = gp[1]; }
  else { g[0] = (f32x4){1.f, 1.f, 1.f, 1.f}; g[1] = g[0]; }
}
DI void conv_proc(const ConvItem& c, int lane, const float (&tmp)[32], const f32x4 (&g)[2], LAS float* scr) {
#pragma unroll
  for (int i = 0; i < 32; ++i) { const int kk = 2 * i + (lane >> 5); scr[kk * 33 + (lane & 31)] = tmp[i]; }
  asm volatile("s_waitcnt lgkmcnt(0)" ::: "memory"); __builtin_amdgcn_wave_barrier();
  const int cc = lane & 7; const f32x4 g0 = g[0] * c.scale, g1 = g[1] * c.scale;
#pragma unroll
  for (int j = 0; j < 4; ++j) {
    const int n = (lane >> 3) + 8 * j; const LAS float* sp = scr + (8 * cc) * 33 + n;
    u32x4 o; o.x = cvt_pk(sp[0] * g0[0], sp[33] * g0[1]); o.y = cvt_pk(sp[66] * g0[2], sp[99] * g0[3]); o.z = cvt_pk(sp[132] * g1[0], sp[165] * g1[1]); o.w = cvt_pk(sp[198] * g1[2], sp[231] * g1[3]);
    *(u32x4*)(c.dst + (size_t)(c.drow + n) * c.K + c.k0 + 8 * cc) = o;
  }
  asm volatile("s_waitcnt lgkmcnt(0)" ::: "memory"); __builtin_amdgcn_wave_barrier();
}

DI void conv_phase(KP p, int layer, LAS unsigned char* lds) {
  const int tid = opaque_tid(), wid = tid >> 6, lane = tid & 63;
  LAS float* scr = (LAS float*)(lds + wid * 8448);
  const int gw = blockIdx.x * 8 + wid, ngw = gridDim.x * 8;
  unsigned char* ws = p->ws;
  const float* ng = p->in[2] + (size_t)layer * 3 * DM;
  bf16_t* WM = (bf16_t*)(ws + OFF_W + W_MIX);
  const int mx = layer % 3, j = layer / 3;
  const float* g1 = ng + DM;
  auto decode = [&](int f, ConvItem& c) __attribute__((always_inline)) -> bool {
    int r = f; c.scale = 1.f; c.rp = false; c.gain = nullptr;
#define CJ_PLAIN(SRC, LD, SCOL0, DST, KK, DROW0, NROWS, GAIN, SCALE, RMODE) { const int nkb_ = (KK) / 64, nblk_ = (NROWS) / 32, items_ = nkb_ * nblk_; \
      if (r < items_) { const int nb_ = r % nblk_, kb_ = r / nblk_; c.src = (SRC);     c.ld = (LD); c.scol = (SCOL0) + 32 * nb_; c.dst = (DST); c.K = (KK); c.drow = (DROW0) + 32 * nb_; c.k0 = 64 * kb_; \
        c.gain = (GAIN); c.scale = (SCALE); c.rp = (RMODE) == 1 ? (nb_ % 3 == 2) : ((RMODE) == 2 ? nb_ == nblk_ - 1 : false); return true; } r -= items_; }
    for (int s2 = 0; s2 < 2; ++s2) {
      const size_t wo_ = ((size_t)layer * 2 + s2) * DM * FF;
      { const int items_ = 16 * (5632 / 32);
        if (r < items_) { const int nb_ = r % 176, kb_ = r / 176, row0 = 32 * nb_, pn_ = row0 >> 8, wi = row0 & 255;
          c.src = (wi < 128 ? p->in[4] : p->in[5]) + wo_; c.ld = FF; c.scol = pn_ * 128 + (wi & 127); c.dst = (bf16_t*)(ws + OFF_W + (s2 ? W_GU1 : W_GU0)); c.K = 1024; c.drow = row0; c.k0 = 64 * kb_;
          c.gain = ng + (s2 ? 2 * DM : 0); return true; } r -= items_; }
      CJ_PLAIN(p->in[6] + wo_, DM, 0, (bf16_t*)(ws + OFF_W + (s2 ? W_DN1 : W_DN0)), FF, 0, DM, (const float*)nullptr, 1.f, 0)
    }
    if (mx == 0) {
      bf16_t* wc_ = WM; bf16_t* wq = wc_ + 1024 * 1024; bf16_t* wkv = wq + 1536 * 512; bf16_t* wo = wkv + 2048 * 256;
      CJ_PLAIN(p->in[8] + (size_t)j * 1024 * 512, 512, 0, wc_, 1024, 0, 512, g1, 1.f, 0)
      CJ_PLAIN(p->in[11] + (size_t)j * 1024 * 288, 288, 0, wc_, 1024, 512, 288, g1, 1.f, 2)
      CJ_PLAIN((const float*)nullptr, 0, 0, wc_, 1024, 800, 224, (const float*)nullptr, 1.f, 0)
      CJ_PLAIN(p->in[10] + (size_t)j * 512 * 1536, 1536, 0, wq, 512, 0, 1536, p->in[9] + j * 512, 0.10206207261596575f * LOG2E, 1)
      CJ_PLAIN(p->in[13] + (size_t)j * 256 * 1024, 1024, 0, wkv, 256, 0, 1024, p->in[12] + j * 256, 1.f, 0)
      CJ_PLAIN(p->in[14] + (size_t)j * 256 * 1024, 1024, 0, wkv, 256, 1024, 1024, p->in[12] + j * 256, 1.f, 0)
      CJ_PLAIN(p->in[15] + (size_t)j * 1024 * 1024, 1024, 0, wo, 1024, 0, 1024, (const float*)nullptr, 1.f, 0)
    } else if (mx == 1) {
      bf16_t* wqkv = WM; bf16_t* wo = wqkv + 3072 * 1024;
      CJ_PLAIN(p->in[16], 1024, 0, wqkv, 1024, 0, 1024, g1, 0.125f * LOG2E, 0)
      CJ_PLAIN(p->in[17], 1024, 0, wqkv, 1024, 1024, 1024, g1, 1.f, 0)
      CJ_PLAIN(p->in[18], 1024, 0, wqkv, 1024, 2048, 1024, g1, 1.f, 0)
      CJ_PLAIN(p->in[24], 1024, 0, wo, 1024, 0, 1024, (const float*)nullptr, 1.f, 0)
    } else {
      bf16_t* wqkv = WM; bf16_t* wo = wqkv + 3072 * 1024;
      CJ_PLAIN(p->in[25], 3072, 0, wqkv, 1024, 0, 1024, g1, 0.125f * LOG2E, 0)
      CJ_PLAIN(p->in[25], 3072, 1024, wqkv, 1024, 1024, 2048, g1, 1.f, 0)
      CJ_PLAIN(p->in[27], 1024, 0, wo, 1024, 0, 1024, (const float*)nullptr, 1.f, 0)
    }
#undef CJ_PLAIN
    return false;
  };
  {
    ConvItem cur, nxt; float ta[32], tb[32]; f32x4 ga[2], gb[2];
    bool v = decode(gw, cur);
    if (v) conv_load(cur, lane, ta, ga);
    for (int f = gw; v;) {
      const int fn = f + ngw; const bool vn = decode(fn, nxt);
      if (vn) conv_load(nxt, lane, tb, gb);
      conv_proc(cur, lane, ta, ga, scr);
      cur = nxt;
#pragma unroll
      for (int i = 0; i < 32; ++i) ta[i] = tb[i];
      ga[0] = gb[0]; ga[1] = gb[1]; v = vn; f = fn;
    }
  }
  if (layer == 0) {
    bf16_t* XB = (bf16_t*)(ws + OFF_XR); float* P4 = (float*)(ws + OFF_P4);
    for (int row = gw; row < T; row += ngw) {
      const float* xr = row < 16384 ? p->in[0] + (size_t)row * DM : p->in[1] + (size_t)(row - 16384) * DM;
      float ss = 0.f;
#pragma unroll
      for (int q = 0; q < 4; ++q) {
        const f32x4 v = *(const f32x4*)(xr + 256 * q + 4 * lane);
        *(u32x2*)(XB + (size_t)row * DM + 256 * q + 4 * lane) = pk4(v);
        ss += (v[0] * v[0] + v[1] * v[1]) + (v[2] * v[2] + v[3] * v[3]);
      }
#pragma unroll
      for (int o = 1; o < 64; o <<= 1) ss += __shfl_xor(ss, o);
      if (lane < 4) P4[(size_t)lane * T + row] = lane == 0 ? ss : 0.f;
    }
    float* rope = (float*)(ws + OFF_ROPE);
    for (int e = blockIdx.x * 512 + tid; e < 8192 * 16; e += gridDim.x * 512) {
      const int pos = e >> 4, dd = e & 15; float s, c; sincos_f((float)pos * FREQ[dd], s, c);
      rope[e] = c; rope[8192 * 16 + e] = s;
    }
  }
}

constexpr int ATT_KB = 0, ATT_VB = 26624, ATT_LUT = 63488;
DI int crow(int reg, int h) { return (reg & 3) + 8 * (reg >> 2) + 4 * h; }

typedef float f32x2v __attribute__((ext_vector_type(2)));
constexpr float ATT_THR = 8.f;

template <int DK, int DV, int MODE>
DI void flash_pass(LAS unsigned char* lds, const bf16_t* Qw, int ldq, const bf16_t* Kb, int ldk, const bf16_t* Vseq, int c0, int kv0, int L, int ntiles,
                   int rel0, const LAS float* lut, int ka0, int ri, int rs_w, int cw, f32x16 (&O)[DV / 32], float& ltot) {
  constexpr int KSTR = DK * 2 + 16, KBUF = 64 * KSTR, VSTR = 144, VBUF = DV * VSTR, KC8 = DK / 8, NKC = 64 * KC8, KI = (NKC + 511) / 512, VI = DV * 8 / 512;
  const int tid = opaque_tid(), lane = tid & 63, r = lane & 31, hh = lane >> 5;
#define FA_BAR do { asm volatile("s_waitcnt lgkmcnt(0)" ::: "memory"); __builtin_amdgcn_s_barrier(); asm volatile("" ::: "memory"); } while (0)
  bf16x8 qf[DK / 16];
#pragma unroll
  for (int kk = 0; kk < DK / 16; ++kk) qf[kk] = *(const bf16x8*)(Qw + (size_t)r * ldq + 16 * kk + 8 * hh);
#pragma unroll
  for (int db = 0; db < DV / 32; ++db)
#pragma unroll
    for (int i = 0; i < 16; ++i) O[db][i] = 0.f;
  float mrun = -INFINITY, lsum = 0.f;
  unsigned nacolp[8];
  if (MODE == 1) {
    const int c = cw + r; int cs = c - 8; cs = cs < 0 ? 0 : (cs > 48 ? 48 : cs);
#pragma unroll
    for (int q = 0; q < 8; ++q) { unsigned wv = 0;
#pragma unroll
      for (int b4 = 0; b4 < 4; ++b4) { const int j = 4 * q + b4, kb = j >> 4, i = j & 15; const int e = 32 * kb + (i & 3) + 8 * (i >> 2) + 4 * hh; const bool valid = (e >= cs) && (e < cs + 16);
        wv |= (unsigned)(valid ? (e - c + 15) * 4 : 31 * 4) << (8 * b4); }
      nacolp[q] = wv; }
  }
  u32x4 kr[KI], vr[VI];
  int krow_[KI], kc8_[KI];
#pragma unroll
  for (int i = 0; i < KI; ++i) { const int c = tid + 512 * i; krow_[i] = c / KC8; kc8_[i] = c % KC8; }
#define FA_LOADK(t) do { _Pragma("unroll") for (int i = 0; i < KI; ++i) if (tid + 512 * i < NKC) kr[i] = *(const u32x4*)(Kb + (size_t)((t) * 64 + krow_[i]) * ldk + kc8_[i] * 8); } while (0)
#define FA_LOADV(t) do { _Pragma("unroll") for (int i = 0; i < VI; ++i) { const int c = tid + 512 * i, cg_ = c0 + (c >> 3); vr[i] = *(const u32x4*)(Vseq + (size_t)cg_ * L + ((kv0 + 64 * ((t) + cg_)) & (L - 1)) + (c & 7) * 8); } } while (0)
#define FA_STOREK(b) do { _Pragma("unroll") for (int i = 0; i < KI; ++i) if (tid + 512 * i < NKC) *(LAS u32x4*)(lds + ATT_KB + (b) * KBUF + krow_[i] * KSTR + kc8_[i] * 16) = kr[i]; } while (0)
#define FA_STOREV(b) do { _Pragma("unroll") for (int i = 0; i < VI; ++i) { const int c = tid + 512 * i; LAS unsigned char* vp_ = lds + ATT_VB + (b) * VBUF + (c >> 3) * VSTR + ((c & 7) >> 1) * 32 + (c & 1) * 8; \
    u32x2 lo_, hi_; lo_.x = vr[i].x; lo_.y = vr[i].y; hi_.x = vr[i].z; hi_.y = vr[i].w; *(LAS u32x2*)vp_ = lo_; *(LAS u32x2*)(vp_ + 16) = hi_; } } while (0)
#define FA_SCORE(dst, bvar, tt) do { float cadd_ = 0.f; if (MODE == 0) { const int d0_ = rel0 + 64 * (tt); cadd_ = (d0_ - 31 >= 91) ? cpos : ((d0_ + 63 <= -91) ? cneg : 0.f); }     \
      const float mb_ = (mrun == -INFINITY) ? 0.f : mrun; bvar = mb_; const float init_ = cadd_ - mb_;     \
      _Pragma("unroll") for (int kb = 0; kb < 2; ++kb) { bf16x8 kf_[DK / 16]; \
      _Pragma("unroll") for (int kk = 0; kk < DK / 16; ++kk) \
        kf_[kk] = *(const LAS bf16x8*)(lds + ATT_KB + ((tt) & 1) * KBUF + (32 * kb + r) * KSTR + (16 * kk + 8 * hh) * 2); \
      _Pragma("unroll") for (int i = 0; i < 16; ++i) dst[kb][i] = init_; \
      _Pragma("unroll") for (int kk = 0; kk < DK / 16; ++kk) dst[kb] = __builtin_amdgcn_mfma_f32_32x32x16_bf16(kf_[kk], qf[kk], dst[kb], 0, 0, 0); } } while (0)
  auto part1 = [&](f32x16 (&st)[2], float mbase, int t) __attribute__((always_inline)) {
    if (MODE == 0) {
      const int d0 = rel0 + 64 * t;
      if (!(d0 - 31 >= 91) && !(d0 + 63 <= -91)) {
        const LAS float* lp = lut + (d0 - r + 4 * hh + 256);
#pragma unroll
        for (int kb = 0; kb < 2; ++kb)
#pragma unroll
          for (int i = 0; i < 16; ++i) st[kb][i] += lp[32 * kb + (i & 3) + 8 * (i >> 2)];
      }
    } else {
      const int ka = ka0 + t;
      const LAS unsigned char* rp = (const LAS unsigned char*)lut + (ka - ri + 7) * 128;
#pragma unroll
      for (int q = 0; q < 8; ++q) { unsigned wv = nacolp[q]; asm volatile("" : "+v"(wv));
#pragma unroll
        for (int b4 = 0; b4 < 4; ++b4) { const int j = 4 * q + b4; st[j >> 4][j & 15] += *(const LAS float*)(rp + ((wv >> (8 * b4)) & 0xffu)); } }
    }
    float mx = fmaxf(st[0][0], st[1][0]);
#pragma unroll
    for (int i = 1; i < 16; ++i) mx = fmaxf(fmaxf(mx, st[0][i]), st[1][i]);
    mx = fmaxf(mx, __shfl_xor(mx, 32));
    const float mabs = mx + mbase;
    if (__any(mabs > mrun + ATT_THR)) {
      const float mn = fmaxf(mrun, mabs), alpha = fexp2(mrun - mn); mrun = mn; lsum *= alpha;
#pragma unroll
      for (int db = 0; db < DV / 32; ++db)
#pragma unroll
        for (int i = 0; i < 16; ++i) O[db][i] *= alpha;
    }
    const float delta = mrun - mbase;
    if (__any(delta != 0.f)) {
#pragma unroll
      for (int kb = 0; kb < 2; ++kb)
#pragma unroll
        for (int i = 0; i < 16; ++i) st[kb][i] -= delta;
    }
  };
  auto part2 = [&](f32x16 (&st)[2], int t) __attribute__((always_inline)) {
    float ps0 = 0.f, ps1 = 0.f, ps2 = 0.f, ps3 = 0.f;
#pragma unroll
    for (int kb = 0; kb < 2; ++kb)
#pragma unroll
      for (int i = 0; i < 16; i += 4) {
        const float p0 = fexp2(st[kb][i]), p1 = fexp2(st[kb][i + 1]), p2 = fexp2(st[kb][i + 2]), p3 = fexp2(st[kb][i + 3]);
        st[kb][i] = p0; st[kb][i + 1] = p1; st[kb][i + 2] = p2; st[kb][i + 3] = p3; ps0 += p0; ps1 += p1; ps2 += p2; ps3 += p3;
      }
    lsum += (ps0 + ps1) + (ps2 + ps3);
    bf16x8 pf[2][2];
#pragma unroll
    for (int kb = 0; kb < 2; ++kb)
#pragma unroll
      for (int s = 0; s < 2; ++s) { u32x4 pp; pp.x = cvt_pk(st[kb][8 * s], st[kb][8 * s + 1]); pp.y = cvt_pk(st[kb][8 * s + 2], st[kb][8 * s + 3]); pp.z = cvt_pk(st[kb][8 * s + 4], st[kb][8 * s + 5]); pp.w = cvt_pk(st[kb][8 * s + 6], st[kb][8 * s + 7]); pf[kb][s] = __builtin_bit_cast(bf16x8, pp); }
#pragma unroll
    for (int db = 0; db < DV / 32; ++db)
#pragma unroll
      for (int kb = 0; kb < 2; ++kb)
#pragma unroll
        for (int s = 0; s < 2; ++s) {
          const bf16x8 vf = *(const LAS bf16x8*)(lds + ATT_VB + (t & 1) * VBUF + (32 * db + r) * VSTR + (2 * kb + s) * 32 + hh * 16);
          O[db] = __builtin_amdgcn_mfma_f32_32x32x16_bf16(vf, pf[kb][s], O[db], 0, 0, 0);
        }
  };
#define FA_STEP(t, cur, bcur, nxt, bnxt) do { \
    FA_STOREK((t) & 1); FA_STOREV(((t) + 1) & 1); \
    FA_LOADK(((t) + 3 < ntiles) ? (t) + 3 : ntiles - 1); FA_LOADV(((t) + 2 < ntiles) ? (t) + 2 : ntiles - 1); \
    bool act_ = true; if (MODE == 1) { const int ka_ = ka0 + (t); act_ = (ka_ >= rs_w) && (ka_ < rs_w + 8); } \
    if (act_) part1(cur, bcur, (t)); \
    __builtin_amdgcn_s_setprio(1);     \
    FA_SCORE(nxt, bnxt, (t) + 1); \
    if (act_) part2(cur, (t)); \
    __builtin_amdgcn_s_setprio(0); \
    FA_BAR; } while (0)
  f32x16 stA[2], stB[2]; float baseA = 0.f, baseB = 0.f;
  {
    u32x4 kr1[KI]; const int t1_ = ntiles > 1 ? 1 : 0;
    FA_LOADK(0); FA_LOADV(0);
#pragma unroll
    for (int i = 0; i < KI; ++i) if (tid + 512 * i < NKC) kr1[i] = *(const u32x4*)(Kb + (size_t)(t1_ * 64 + krow_[i]) * ldk + kc8_[i] * 8);
    FA_STOREK(0); FA_STOREV(0);
#pragma unroll
    for (int i = 0; i < KI; ++i) if (tid + 512 * i < NKC) *(LAS u32x4*)(lds + ATT_KB + KBUF + krow_[i] * KSTR + kc8_[i] * 16) = kr1[i];
  }
  FA_LOADK(ntiles > 2 ? 2 : ntiles - 1);
  FA_LOADV(ntiles > 1 ? 1 : 0);
  FA_BAR;
  float cpos = 0.f, cneg = 0.f; if (MODE == 0) { cpos = lut[512]; cneg = lut[0]; }
  FA_SCORE(stA, baseA, 0);
  FA_BAR;
  for (int t = 0; t < ntiles; t += 2) {
    FA_STEP(t, stA, baseA, stB, baseB);
    if (t + 1 < ntiles) FA_STEP(t + 1, stB, baseB, stA, baseA);
  }
  ltot = lsum + __shfl_xor(lsum, 32);
#undef FA_LOADK
#undef FA_LOADV
#undef FA_STOREK
#undef FA_STOREV
#undef FA_SCORE
#undef FA_STEP
#undef FA_BAR
}

DI void unit_map(int idx, int nheads, int& tb, int& L, int& head, int& qb) {
  const int nS = 2 * nheads * 32;
  int g;
  if (idx < nS) { const int round = idx >> 8, blk = idx & 255; g = round * 8 + (blk & 7); qb = blk >> 3; L = 8192; const int seq = g / nheads; head = g % nheads; tb = 16384 + seq * 8192; }
  else { const int i2 = idx - nS; const int round = i2 >> 8, blk = i2 & 255; g = round * 32 + (blk & 7) * 4 + ((blk >> 3) >> 3); qb = (blk >> 3) & 7; L = 2048; const int seq = g / nheads; head = g % nheads; tb = seq * 2048; }
}
DI void t5_lut(LAS float* lut, const float* table, int head, int tid) {
  for (int e = tid; e < 513; e += 512) { const int rel = e - 256, n = rel < 0 ? -rel : rel; int b = n; if (n >= 8) { b = n >= 128 ? 15 : 8 + (31 - __clz(n * n)) - 6; if (b > 15) b = 15; }
    lut[e] = table[((rel > 0 ? 16 : 0) + b) * 16 + head] * LOG2E; }
}

DI void att_mla_phase(KP p, LAS unsigned char* lds) {
  const int tid = opaque_tid(), w = tid >> 6, lane = tid & 63, r = lane & 31, hh = lane >> 5;
  const bf16_t* Q = (const bf16_t*)(p->ws + OFF_BIG + 64 * MiB); const bf16_t* Kf = (const bf16_t*)(p->ws + OFF_BIG + 160 * MiB);
  const bf16_t* Vt = (const bf16_t*)(p->ws + OFF_A); bf16_t* Oo = (bf16_t*)(p->ws + OFF_BIG);
  LAS float* lut = (LAS float*)(lds + ATT_LUT);
  for (int idx = blockIdx.x; idx < 2048; idx += gridDim.x) {
    int tb, L, head, qb; unit_map(idx, 16, tb, L, head, qb);
    t5_lut(lut, p->in[7], head, tid);
    const int q0w = qb * 256 + 32 * w;
    f32x16 O[2]; float lt;
    flash_pass<96, 64, 0>(lds, Q + (size_t)(tb + q0w) * 1536 + head * 96, 1536, Kf + (size_t)tb * 1536 + head * 96, 1536, Vt + (size_t)tb * DM, head * 64, 0, L, L / 64,
                          -q0w, lut, 0, 0, 0, 0, O, lt);
    const float inv = 1.f / lt;
    bf16_t* op = Oo + (size_t)(tb + q0w + r) * DM + head * 64 + 4 * hh;
#pragma unroll
    for (int db = 0; db < 2; ++db)
#pragma unroll
      for (int g = 0; g < 4; ++g) { f32x4 v; v[0] = O[db][4 * g] * inv; v[1] = O[db][4 * g + 1] * inv; v[2] = O[db][4 * g + 2] * inv; v[3] = O[db][4 * g + 3] * inv; *(u32x2*)(op + 32 * db + 8 * g) = pk4(v); }
  }
}

DI void att_diff_phase(KP p, int layer, LAS unsigned char* lds) {
  const int tid = opaque_tid(), w = tid >> 6, lane = tid & 63, r = lane & 31, hh = lane >> 5;
  const bf16_t* Q = (const bf16_t*)(p->ws + OFF_BIG); const bf16_t* Kd = (const bf16_t*)(p->ws + OFF_BIG + 64 * MiB);
  const bf16_t* Vt = (const bf16_t*)(p->ws + OFF_BIG + 128 * MiB); bf16_t* Oo = (bf16_t*)(p->ws + OFF_BIG + 192 * MiB);
  LAS float* lut = (LAS float*)(lds + ATT_LUT);
  float d1 = p->in[19][lane] * p->in[20][lane], d2 = p->in[21][lane] * p->in[22][lane];
#pragma unroll
  for (int o = 1; o < 64; o <<= 1) { d1 += __shfl_xor(d1, o); d2 += __shfl_xor(d2, o); }
  const float lam_init = 0.8f - 0.6f * expf(-0.3f * (float)layer);
  const float lam = expf(d1) - expf(d2) + lam_init;
  for (int idx = blockIdx.x; idx < 1024; idx += gridDim.x) {
    int tb, L, head, qb; unit_map(idx, 8, tb, L, head, qb);
    const int q0w = qb * 256 + 32 * w;
    f32x16 O0[4]; float lt0, lt1;
    t5_lut(lut, p->in[7], 2 * head, tid);
    flash_pass<64, 128, 0>(lds, Q + (size_t)(tb + q0w) * DM + (2 * head) * 64, DM, Kd + (size_t)tb * DM + (2 * head) * 64, DM, Vt + (size_t)tb * DM, head * 128, 0, L, L / 64,
                           -q0w, lut, 0, 0, 0, 0, O0, lt0);
    float* scr0 = (float*)(p->ws + OFF_A) + ((size_t)blockIdx.x * 512 + tid) * 64;
    { const float i0 = 1.f / lt0;
#pragma unroll
      for (int db = 0; db < 4; ++db)
#pragma unroll
        for (int i = 0; i < 16; i += 4) { f32x4 v; v[0] = O0[db][i] * i0; v[1] = O0[db][i + 1] * i0; v[2] = O0[db][i + 2] * i0; v[3] = O0[db][i + 3] * i0; *(f32x4*)(scr0 + db * 16 + i) = v; } }
    t5_lut(lut, p->in[7], 2 * head + 1, tid);
    flash_pass<64, 128, 0>(lds, Q + (size_t)(tb + q0w) * DM + (2 * head + 1) * 64, DM, Kd + (size_t)tb * DM + (2 * head + 1) * 64, DM, Vt + (size_t)tb * DM, head * 128, 0, L, L / 64,
                           -q0w, lut, 0, 0, 0, 0, O0, lt1);
    const float i1 = lam / lt1;
    const float* scr1 = scr0; asm volatile("" : "+v"(scr1));
    float ss = 0.f;
#pragma unroll
    for (int db = 0; db < 4; ++db)
#pragma unroll
      for (int i = 0; i < 16; i += 4) { const f32x4 v = *(const f32x4*)(scr1 + db * 16 + i);
#pragma unroll
        for (int e = 0; e < 4; ++e) { const float a = v[e] - O0[db][i + e] * i1; O0[db][i + e] = a; ss += a * a; } }
    ss += __shfl_xor(ss, 32);
    const float sc = rsqrtf(ss * (1.f / 128.f) + EPS) * (1.f - lam_init);
    bf16_t* op = Oo + (size_t)(tb + q0w + r) * DM + head * 128 + 4 * hh;
    const float* gs = p->in[23] + 4 * hh;
#pragma unroll
    for (int db = 0; db < 4; ++db)
#pragma unroll
      for (int g = 0; g < 4; ++g) { const f32x4 gv = *(const f32x4*)(gs + 32 * db + 8 * g); f32x4 v; v[0] = O0[db][4 * g] * sc * gv[0]; v[1] = O0[db][4 * g + 1] * sc * gv[1]; v[2] = O0[db][4 * g + 2] * sc * gv[2]; v[3] = O0[db][4 * g + 3] * sc * gv[3];
        *(u32x2*)(op + 32 * db + 8 * g) = pk4(v); }
  }
}

DI void att_na_phase(KP p, LAS unsigned char* lds) {
  const int tid = opaque_tid(), w = tid >> 6, lane = tid & 63, r = lane & 31, hh = lane >> 5;
  const bf16_t* Q = (const bf16_t*)(p->ws + OFF_BIG); const bf16_t* Kd = (const bf16_t*)(p->ws + OFF_BIG + 64 * MiB);
  const bf16_t* Vt = (const bf16_t*)(p->ws + OFF_BIG + 128 * MiB); bf16_t* Oo = (bf16_t*)(p->ws + OFF_BIG + 192 * MiB);
  LAS float* lut = (LAS float*)(lds + ATT_LUT);
  for (int idx = blockIdx.x; idx < 2048; idx += gridDim.x) {
    int tb, L, head, qb; unit_map(idx, 16, tb, L, head, qb);
    if (tid < 480) { const int rw = tid >> 5, cl = tid & 31; lut[tid] = cl < 31 ? p->in[26][head * 465 + rw * 31 + cl] * LOG2E : -1e30f; }
    const int rows = L / 64, R0 = 4 * qb, ri = R0 + (w >> 1), cw = 32 * (w & 1);
    int rs_w = ri - 4; rs_w = rs_w < 0 ? 0 : (rs_w > rows - 8 ? rows - 8 : rs_w);
    int ka_lo = R0 - 4; ka_lo = ka_lo < 0 ? 0 : (ka_lo > rows - 8 ? rows - 8 : ka_lo);
    int ka_hi = R0 - 1; ka_hi = (ka_hi < 0 ? 0 : (ka_hi > rows - 8 ? rows - 8 : ka_hi)) + 7;
    const int q0w = R0 * 64 + 32 * w;
    f32x16 O[2]; float lt;
    flash_pass<64, 64, 1>(lds, Q + (size_t)(tb + q0w) * DM + head * 64, DM, Kd + (size_t)(tb + ka_lo * 64) * DM + head * 64, DM, Vt + (size_t)tb * DM, head * 64, ka_lo * 64, L,
                          ka_hi - ka_lo + 1, 0, lut, ka_lo, ri, rs_w, cw, O, lt);
    const float inv = 1.f / lt;
    bf16_t* op = Oo + (size_t)(tb + q0w + r) * DM + head * 64 + 4 * hh;
#pragma unroll
    for (int db = 0; db < 2; ++db)
#pragma unroll
      for (int g = 0; g < 4; ++g) { f32x4 v; v[0] = O[db][4 * g] * inv; v[1] = O[db][4 * g + 1] * inv; v[2] = O[db][4 * g + 2] * inv; v[3] = O[db][4 * g + 3] * inv; *(u32x2*)(op + 32 * db + 8 * g) = pk4(v); }
  }
}

DI void final_phase(KP p) {
  const int tid = opaque_tid(), wid = tid >> 6, lane = tid & 63;
  const float* P4 = (const float*)(p->ws + OFF_P4); const float* fg = p->in[3]; const bf16_t* XR = (const bf16_t*)(p->ws + OFF_XR);
  for (int row = blockIdx.x * 8 + wid; row < T; row += gridDim.x * 8) {
    const float rs = row_rstd(P4, 4, 1.f / 1024.f, row);
#pragma unroll
    for (int q = 0; q < 4; ++q) {
      const u32x2 xw = *(const u32x2*)(XR + (size_t)row * DM + 256 * q + 4 * lane);
      f32x4 v; v[0] = __uint_as_float(xw.x << 16); v[1] = __uint_as_float(xw.x & 0xffff0000u); v[2] = __uint_as_float(xw.y << 16); v[3] = __uint_as_float(xw.y & 0xffff0000u);
      const f32x4 g = *(const f32x4*)(fg + 256 * q + 4 * lane);
      *(f32x4*)(p->out + (size_t)row * DM + 256 * q + 4 * lane) = v * rs * g;
    }
  }
}

#define XB_TMO      128
#define XB_XCNT(j)  (256  + 64 * (j))
#define XB_XSUB(j)  (1280 + 64 * (j))
#define XB_XGEN(j)  (2304 + 64 * (j))
#define XB_TOP      3328
#define XB_TOPGEN   3392
#define XCD_BAR_WORDS 3456
#define XB_SPIN_CAP (1u << 18)
DI unsigned xb_ld(unsigned* p)              { return __hip_atomic_load(p, __ATOMIC_RELAXED, __HIP_MEMORY_SCOPE_AGENT); }
DI unsigned xb_add(unsigned* p, unsigned v) { return __hip_atomic_fetch_add(p, v, __ATOMIC_RELAXED, __HIP_MEMORY_SCOPE_AGENT); }
DI unsigned xb_xcc_id() { return (unsigned)__builtin_amdgcn_s_getreg((3 << 11) | 20) & 0xFu; }
#define XB_SPIN(cond, bar) do { unsigned _sp = 0; while (cond) { __builtin_amdgcn_s_sleep(1); \
    if ((++_sp & 255u) == 0u) { if (xb_ld(&(bar)[XB_TMO])) break; if (_sp > XB_SPIN_CAP) { atomicAdd(&(bar)[XB_TMO], 1u); break; } } } } while (0)
struct XcdBarrier { unsigned* bar; unsigned x; volatile LAS unsigned* st; };
DI XcdBarrier xcd_barrier_post(unsigned* bar, volatile LAS unsigned* st) {
  XcdBarrier b; b.bar = bar; b.x = xb_xcc_id(); b.st = st;
  if (threadIdx.x == 0) (void)xb_add(&bar[XB_XCNT(b.x)], 1u);
  return b;
}
DI void xcd_barrier_complete(unsigned* bar, unsigned x, unsigned& nloc, unsigned& nx) {
  const unsigned G = gridDim.x * gridDim.y * gridDim.z;
  unsigned sum, cnt, mine, sp = 0u;
  for (;;) {
    sum = 0u; cnt = 0u; mine = 0u;
#pragma unroll
    for (unsigned j = 0; j < 16; ++j) { const unsigned c = xb_ld(&bar[XB_XCNT(j)]); sum += c; cnt += (c > 0u) ? 1u : 0u; mine = (j == x) ? c : mine; }
    if (sum == G) break;
    __builtin_amdgcn_s_sleep(1);
    if ((++sp & 255u) == 0u) { if (xb_ld(&bar[XB_TMO])) break; if (sp > XB_SPIN_CAP) { atomicAdd(&bar[XB_TMO], 1u); break; } }
  }
  nloc = mine > 0u ? mine : 1u; nx = cnt > 0u ? cnt : 1u;
}
DI void xcd_barrier(const XcdBarrier& b) {
  asm volatile("s_waitcnt vmcnt(0)" ::: "memory");
  __syncthreads();
  if (threadIdx.x == 0) {
    unsigned* bar = b.bar;
    __builtin_amdgcn_s_waitcnt(0);
    unsigned nloc = b.st[0], nx = b.st[1];
    if (nloc == 0u) { xcd_barrier_complete(bar, b.x, nloc, nx); b.st[0] = nloc; b.st[1] = nx; }
    const unsigned old = xb_add(&bar[XB_XSUB(b.x)], 1u);
    const unsigned gen = old / nloc;
    if (old + 1u == (gen + 1u) * nloc) {
      __builtin_amdgcn_fence(__ATOMIC_RELEASE, "agent");
      asm volatile("s_waitcnt vmcnt(0)" ::: "memory");
      const unsigned og = xb_add(&bar[XB_TOP], 1u);
      const unsigned tg = og / nx;
      if (og + 1u == (tg + 1u) * nx) xb_add(&bar[XB_TOPGEN], 1u);
      else XB_SPIN(xb_ld(&bar[XB_TOPGEN]) == tg, bar);
      __builtin_amdgcn_fence(__ATOMIC_ACQUIRE, "agent");
      xb_add(&bar[XB_XGEN(b.x)], 1u);
      asm volatile("s_waitcnt vmcnt(0)" ::: "memory");
    } else {
      XB_SPIN(xb_ld(&bar[XB_XGEN(b.x)]) == gen, bar);
      __builtin_amdgcn_fence(__ATOMIC_ACQUIRE, "agent");
      asm volatile("s_waitcnt vmcnt(0)" ::: "memory");
    }
  }
  __syncthreads();
}

__global__ void __launch_bounds__(512) mega(Params p_unused) {
  extern __shared__ __attribute__((aligned(16))) unsigned char smem[];
  LAS unsigned char* lds = (LAS unsigned char*)smem;
  cg::grid_group grid = cg::this_grid();
  volatile LAS unsigned* xst = (volatile LAS unsigned*)(lds + 137216);
  if (threadIdx.x == 0) { xst[0] = 0u; xst[1] = 0u; }
  __syncthreads();
  const XcdBarrier xb = xcd_barrier_post(((KP)__builtin_amdgcn_kernarg_segment_ptr())->bar, xst);
  for (int pc = 0; pc < 48; ++pc) {
    KP p = (KP)__builtin_amdgcn_kernarg_segment_ptr(); asm volatile("" : "+s"(p));
    unsigned char* ws = p->ws;
    bf16_t* XB = (bf16_t*)(ws + OFF_XR);
    bf16_t* VTA = (bf16_t*)(ws + OFF_A);
    float* P4 = (float*)(ws + OFF_P4); float* PQ = (float*)(ws + OFF_PQ); float* PKV = (float*)(ws + OFF_PKV);
    const float* rope = (const float*)(ws + OFF_ROPE);
    bf16_t* BIG = (bf16_t*)(ws + OFF_BIG);
    bf16_t* WM = (bf16_t*)(ws + OFF_W + W_MIX);
    const unsigned op = PROG[pc]; const int kind = op & 15, layer = (op >> 4) & 3, sub = (op >> 6) & 1, sync = (op >> 7) & 1;
    if (kind == OP_END) break;
    if (kind == OP_CONV) {
#ifndef NO_CONV
      conv_phase(p, layer, lds);
#endif
    } else if (kind == OP_ATT_MLA) {
#ifndef NO_MLA
      att_mla_phase(p, lds);
#endif
    } else if (kind == OP_ATT_DIFF) {
#ifndef NO_DIFF
      att_diff_phase(p, layer, lds);
#endif
    } else if (kind == OP_ATT_NA) {
#ifndef NO_NA
      att_na_phase(p, lds);
#endif
    } else if (kind == OP_FINAL) final_phase(p);
    else {
#ifndef NO_GEMM
      GemmDesc d; d.nM = T / 256; d.vpn = 1 << 30; d.P = P4; d.np = 4; d.inv_dim = 1.f / 1024.f; d.O0 = nullptr; d.O1 = nullptr; d.O2 = nullptr; d.Pout = P4; d.Pout2 = PKV; d.rope = rope; d.kmode = 0; d.perm = 1; d.ablk = 0;
      const int mx = layer % 3;
      if (kind == OP_FFN_UP) { d.A = XB; d.lda = DM; d.B = (const bf16_t*)(ws + OFF_W + (sub ? W_GU1 : W_GU0)); d.ldb = DM; d.K = DM; d.nN = 22; d.epi = EPI_FFN_UP; d.O0 = BIG; }
      else if (kind == OP_FFN_DOWN) { d.A = BIG; d.lda = FF; d.B = (const bf16_t*)(ws + OFF_W + (sub ? W_DN1 : W_DN0)); d.ldb = FF; d.K = FF; d.nN = 4; d.epi = EPI_RESID; d.O0 = XB; d.ablk = 1; }
      else if (kind == OP_MLA_C) { d.A = XB; d.lda = DM; d.B = WM; d.ldb = DM; d.K = DM; d.nN = 4; d.epi = EPI_MLA_C; d.O0 = BIG; d.O1 = BIG + 80ull * MiB; d.Pout = PQ; d.Pout2 = PKV; }
      else if (kind == OP_MLA_Q) { d.A = BIG; d.lda = DM; d.B = WM + 1024 * 1024; d.ldb = 512; d.K = 512; d.nN = 6; d.epi = EPI_MLA_Q; d.P = PQ; d.np = 2; d.inv_dim = 1.f / 512.f; d.O0 = BIG + 32ull * MiB; }
      else if (kind == OP_MLA_KV) { d.A = BIG + 512; d.lda = DM; d.B = WM + 1024 * 1024 + 1536 * 512; d.ldb = 256; d.K = 256; d.nN = 8; d.vpn = 4; d.epi = EPI_KV; d.P = PKV; d.np = 1; d.inv_dim = 1.f / 256.f; d.kmode = 0; d.O0 = BIG + 80ull * MiB; d.O2 = VTA; }
      else if (kind == OP_QKV) { d.A = XB; d.lda = DM; d.B = WM; d.ldb = DM; d.K = DM; d.nN = 12; d.vpn = 8; d.epi = EPI_KV; d.kmode = 1; d.O0 = BIG; d.O1 = BIG + 32ull * MiB; d.O2 = BIG + 64ull * MiB; }
      else {   d.lda = DM; d.ldb = DM; d.K = DM; d.nN = 4; d.epi = EPI_RESID; d.O0 = XB;
        if (mx == 0) { d.A = BIG; d.B = WM + 1024 * 1024 + 1536 * 512 + 2048 * 256; } else { d.A = BIG + 96ull * MiB; d.B = WM + 3072 * 1024; } }
      const int nparts = d.vpn < d.nN ? 2 : 1;
      _Pragma("nounroll") for (int part = 0; part < nparts; ++part) {
        d.pn0 = part ? d.vpn : 0; d.nNs = part ? d.nN - d.vpn : (d.vpn < d.nN ? d.vpn : d.nN); d.swp = part;
        gemm_phase(lds, d, p->out);
      }
#endif
    }
    if (sync) { if (pc == 0) grid.sync(); else xcd_barrier(xb); }
  }
}

extern "C" void kernel_launch(void* const* d_in, const int* in_sizes, int n_in, void* d_out, int out_size, void* d_ws, size_t ws_size, hipStream_t stream) {
  static int grid_blocks = 0;
  constexpr int LDS_BYTES = 131072 + 2048 + 4096 + 16;
  if (grid_blocks == 0) {
    if (n_in != 28 || out_size != T * DM || ws_size < WS_END) { fprintf(stderr, "kernel_launch: unexpected shapes (n_in %d out %d ws %zu need %zu)\n", n_in, out_size, ws_size, (size_t)WS_END); grid_blocks = -1; return; }
    int dev = 0, cus = 0, per_cu = 0;
    hipGetDevice(&dev); hipDeviceGetAttribute(&cus, hipDeviceAttributeMultiprocessorCount, dev);
    if (hipFuncSetAttribute((const void*)mega, hipFuncAttributeMaxDynamicSharedMemorySize, LDS_BYTES) != hipSuccess) { fprintf(stderr, "hipFuncSetAttribute failed\n"); grid_blocks = -1; return; }
    hipOccupancyMaxActiveBlocksPerMultiprocessor(&per_cu, (const void*)mega, 512, LDS_BYTES);
    if (per_cu < 1) per_cu = 1;
    if (per_cu > 1) per_cu = 1;
    grid_blocks = cus * per_cu;
  }
  if (grid_blocks < 0) return;
  Params p{};
  for (int i = 0; i < 28; ++i) p.in[i] = (const float*)d_in[i];
  p.out = (float*)d_out; p.ws = (unsigned char*)d_ws; p.bar = (unsigned*)((unsigned char*)d_ws + OFF_XBAR);
  if (hipMemsetAsync(p.bar, 0, XCD_BAR_WORDS * sizeof(unsigned), stream) != hipSuccess) { fprintf(stderr, "barrier memset failed\n"); return; }
  void* args[] = {&p};
  hipError_t e = hipLaunchCooperativeKernel((const void*)mega, dim3(grid_blocks), dim3(512), args, LDS_BYTES, stream);
  if (e != hipSuccess) fprintf(stderr, "cooperative launch failed: %s (grid %d)\n", hipGetErrorString(e), grid_blocks);
}
```

```cpp
#include <hip/hip_runtime.h>
#include <hip/hip_cooperative_groups.h>
#include <cstdio>
#include <cstdint>
#include <cmath>
namespace cg = cooperative_groups;

#define LAS __attribute__((address_space(3)))
#define DI __device__ __forceinline__
typedef unsigned short bf16_t;
typedef short bf16x8 __attribute__((ext_vector_type(8)));
typedef short s16x4 __attribute__((ext_vector_type(4)));
typedef float f32x4 __attribute__((ext_vector_type(4)));
typedef float f32x16 __attribute__((ext_vector_type(16)));
typedef unsigned u32x4 __attribute__((ext_vector_type(4)));
typedef unsigned u32x2 __attribute__((ext_vector_type(2)));

constexpr int T = 32768, DM = 1024, FF = 2816;
constexpr float LOG2E = 1.4426950408889634f;
constexpr float EPS = 1e-6f;
constexpr size_t MiB = 1024ull * 1024ull;
constexpr size_t OFF_A = 0;
constexpr size_t OFF_BIG = 64 * MiB;
constexpr size_t OFF_W = 320 * MiB;
constexpr size_t OFF_MISC = 368 * MiB;
constexpr size_t OFF_P4 = OFF_MISC;
constexpr size_t OFF_PQ = OFF_P4 + 4ull * T * 4;
constexpr size_t OFF_PKV = OFF_PQ + 2ull * T * 4;
constexpr size_t OFF_ROPE = OFF_PKV + 1ull * T * 4;
constexpr size_t OFF_XBAR = OFF_MISC + 2 * MiB;
constexpr size_t OFF_XR = OFF_MISC + 3 * MiB;
constexpr size_t WS_END = OFF_XR + 64 * MiB;
constexpr size_t W_GU0 = 0, W_GU_SZ = 5632ull * 1024 * 2, W_DN_SZ = 1024ull * 2816 * 2;
constexpr size_t W_DN0 = W_GU0 + W_GU_SZ, W_GU1 = W_DN0 + W_DN_SZ, W_DN1 = W_GU1 + W_GU_SZ, W_MIX = W_DN1 + W_DN_SZ;

enum { OP_END = 0, OP_CONV, OP_FFN_UP, OP_FFN_DOWN, OP_MLA_C, OP_MLA_Q, OP_MLA_KV, OP_ATT_MLA, OP_WO, OP_QKV, OP_ATT_DIFF, OP_ATT_NA, OP_FINAL };
enum { EPI_FFN_UP = 0, EPI_RESID, EPI_MLA_C, EPI_MLA_Q, EPI_KV };

struct Params {
  const float* in[28];
  float* out;
  unsigned char* ws;
  unsigned* bar;
};
typedef const __attribute__((address_space(4))) Params* KP;
#define OPC(kind, layer, sub, sync) (unsigned char)((kind) | ((layer) << 4) | ((sub) << 6) | ((sync) << 7))
#define LAYER_HEAD(l) OPC(OP_CONV, l, 0, 1), OPC(OP_FFN_UP, l, 0, 1), OPC(OP_FFN_DOWN, l, 0, 1)
#define LAYER_TAIL(l) OPC(OP_WO, l, 0, 1), OPC(OP_FFN_UP, l, 1, 1), OPC(OP_FFN_DOWN, l, 1, 1)
#define LAYER_MLA(l) LAYER_HEAD(l), OPC(OP_MLA_C, l, 0, 1), OPC(OP_MLA_Q, l, 0, 0), OPC(OP_MLA_KV, l, 0, 1), OPC(OP_ATT_MLA, l, 0, 1), LAYER_TAIL(l)
__device__ const unsigned char PROG[48] = {
  LAYER_MLA(0),
  LAYER_HEAD(1), OPC(OP_QKV, 1, 0, 1), OPC(OP_ATT_DIFF, 1, 0, 1), LAYER_TAIL(1),
  LAYER_HEAD(2), OPC(OP_QKV, 2, 0, 1), OPC(OP_ATT_NA, 2, 0, 1), LAYER_TAIL(2),
  LAYER_MLA(3),
  OPC(OP_FINAL, 0, 0, 0), OPC(OP_END, 0, 0, 0) };
__device__ const float FREQ[16] = {1.000000000e+00f, 5.623413324e-01f, 3.162277639e-01f, 1.778279394e-01f, 1.000000015e-01f, 5.623413250e-02f, 3.162277490e-02f, 1.778279431e-02f,
  9.999999776e-03f, 5.623413250e-03f, 3.162277630e-03f, 1.778279431e-03f, 1.000000047e-03f, 5.623413017e-04f, 3.162277571e-04f, 1.778279402e-04f};

DI unsigned cvt_pk(float lo, float hi) { unsigned r; asm volatile("v_cvt_pk_bf16_f32 %0, %1, %2" : "=v"(r) : "v"(lo), "v"(hi)); return r; }
DI u32x2 pk4(f32x4 v) { u32x2 r; r.x = cvt_pk(v[0], v[1]); r.y = cvt_pk(v[2], v[3]); return r; }
DI int opaque_tid() { int t = threadIdx.x; asm volatile("" : "+v"(t)); return t; }
DI float fexp2(float x) { return __builtin_amdgcn_exp2f(x); }
DI float frcp(float x) { return __builtin_amdgcn_rcpf(x); }
DI void tok_info(int t, int& tb, int& L, int& pos) {
  if (t < 16384) { L = 2048; tb = t & ~2047; pos = t & 2047; }
  else { L = 8192; const int u = t - 16384; tb = 16384 + (u & ~8191); pos = u & 8191; }
}

constexpr int BK = 64, HTB = 128 * BK * 2;
DI int lds_byte(int r, int c) { const int st = (r >> 4) * 2 + (c >> 5), rr = r & 15, cc = c & 31, ob = rr * 64 + cc * 2; return st * 1024 + (ob ^ (((ob >> 9) & 1) << 5)); }
DI void stage_rc(int b, int& R, int& C) { const int st = b / 1024, sb = b % 1024, swz = sb ^ (((sb >> 9) & 1) << 5); R = (st >> 1) * 16 + swz / 64; C = (st & 1) * 32 + (swz % 64) / 2; }

DI int perm32(int rho) { const int n = rho >> 4, i = rho & 15; return 8 * (i >> 2) + 4 * n + (i & 3); }
struct GemmDesc {
  const bf16_t* A; int lda; const bf16_t* B; int ldb; int K, nM, nN, epi, vpn;
  const float* P; int np; float inv_dim;
  bf16_t* O0; bf16_t* O1; bf16_t* O2; float* Pout; float* Pout2;
  const float* rope; int kmode; int perm; int ablk; int pn0, nNs, swp;
};

DI float row_rstd(const float* P, int np, float inv_dim, int row) {
  float s = P[row];
  if (np > 1) s += P[T + row];
  if (np > 2) s += P[2 * T + row] + P[3 * T + row];
  return rsqrtf(s * inv_dim + EPS);
}

#ifdef ONLY_EPI
#define EPI_ON(x) ((x) == ONLY_EPI && d.epi == (x))
#else
#define EPI_ON(x) (d.epi == (x))
#endif

#define G_LBAR do { asm volatile("s_waitcnt lgkmcnt(0)" ::: "memory"); __builtin_amdgcn_s_barrier(); asm volatile("" ::: "memory"); } while (0)
DI void gemm_phase(LAS unsigned char* lds, const GemmDesc& d, float* __restrict__ X) {
  const int nwg = d.nM * d.nNs, G = gridDim.x, c = blockIdx.x;
  const bool sw = d.swp != 0;
  auto tile_of = [&](int it, int& pm, int& pn) __attribute__((always_inline)) -> bool {
    const long Lx = (long)it * G + c; if (Lx >= nwg) return false;
    int wgid = (int)Lx; { const int q = nwg / 8, r = nwg % 8, xcd = wgid % 8, off = wgid / 8; wgid = (xcd < r ? xcd * (q + 1) : r * (q + 1) + (xcd - r) * q) + off; }
    const int nig = 8 * d.nNs, gid = wgid / nig, fm = gid * 8, gsz = (d.nM - fm) < 8 ? (d.nM - fm) : 8;
    pm = fm + ((wgid % nig) % gsz); pn = d.pn0 + (wgid % nig) / gsz; return true; };
  const int la = d.ablk ? 64 : (sw ? d.ldb : d.lda), lb = sw ? d.lda : d.ldb;
  const size_t kstepA = d.ablk ? (size_t)(256 * 64 * 2) : (size_t)128, kstepB = 128;
  const size_t hstepA = (size_t)256 * la, hstepB = (size_t)256 * lb;
  auto opA = [&](int pm, int pn) __attribute__((always_inline)) -> const char* { return (const char*)(sw ? d.B + (size_t)pn * 256 * d.ldb : d.A + (size_t)pm * 256 * d.lda); };
  auto opB = [&](int pm, int pn) __attribute__((always_inline)) -> const char* { return (const char*)(sw ? d.A + (size_t)pm * 256 * d.lda : d.B + (size_t)pn * 256 * d.ldb); };
  __syncthreads();
  int pm, pn; if (!tile_of(0, pm, pn)) return;
  const int ktid = opaque_tid(), kwid = __builtin_amdgcn_readfirstlane(ktid >> 6), klane = ktid & 63, kwr = kwid >> 2, kwc = kwid & 3, kfr = klane & 15, kfq = klane >> 4;
  unsigned voffA[2], voffB[2];
#pragma unroll
  for (int i = 0; i < 2; ++i) { int R, C; stage_rc(ktid * 16 + i * 8192, R, C); const int Rb = d.perm ? ((R & ~31) + perm32(R & 31)) : R; voffA[i] = (unsigned)(R * la + C) * 2u; voffB[i] = (unsigned)(Rb * lb + C) * 2u; }
  const unsigned ldsw = (unsigned)kwid * 1024u;
  const int aoff = lds_byte(kwr * 64 + kfr, kfq * 8), boff = lds_byte(kwc * 32 + kfr, kfq * 8);
  const int nt = d.K / BK;
#define S_SA(b, h) (((b) * 2 + (h)) * HTB)
#define S_SB(b, h) ((4 + (b) * 2 + (h)) * HTB)
#define S_STAGE(bufoff, gbase, voff) do { _Pragma("unroll") for (int _i = 0; _i < 2; ++_i) \
    __builtin_amdgcn_global_load_lds((const unsigned*)((gbase) + (voff)[_i]), (LAS unsigned*)(lds + (bufoff) + ldsw + _i * 8192), 16, 0, 0); } while (0)
#define S_LDA(dst, b, h) do { _Pragma("unroll") for (int m = 0; m < 4; ++m) _Pragma("unroll") for (int k = 0; k < 2; ++k) dst[m][k] = *(const LAS bf16x8*)(lds + S_SA(b, h) + aoff + m * 2048 + k * 1024); } while (0)
#define S_LDB(dst, b, h) do { _Pragma("unroll") for (int n = 0; n < 2; ++n) _Pragma("unroll") for (int k = 0; k < 2; ++k) dst[n][k] = *(const LAS bf16x8*)(lds + S_SB(b, h) + boff + n * 2048 + k * 1024); } while (0)
#define S_MMA(ai, bj, At_, Bt_) do { __builtin_amdgcn_s_setprio(1); _Pragma("unroll") for (int m = 0; m < 4; ++m) _Pragma("unroll") for (int n = 0; n < 2; ++n) _Pragma("unroll") for (int k = 0; k < 2; ++k) \
    acc[ai][bj][m][n] = __builtin_amdgcn_mfma_f32_16x16x32_bf16(Bt_[n][k], At_[m][k], acc[ai][bj][m][n], 0, 0, 0); __builtin_amdgcn_s_setprio(0); } while (0)
#define S_WAIT_V(n) asm volatile("s_waitcnt vmcnt(" #n ")" ::: "memory")
#define S_WAIT_L(n) asm volatile("s_waitcnt lgkmcnt(" #n ")" ::: "memory")
#define S_BAR __builtin_amdgcn_s_barrier()
#define S_SCHED __builtin_amdgcn_sched_barrier(0)
  f32x4 acc[2][2][4][2];
#pragma unroll
  for (int a = 0; a < 2; ++a)
#pragma unroll
    for (int b = 0; b < 2; ++b)
#pragma unroll
      for (int m = 0; m < 4; ++m)
#pragma unroll
        for (int n = 0; n < 2; ++n) acc[a][b][m][n] = (f32x4){0.f, 0.f, 0.f, 0.f};
  bf16x8 At[4][2], B0[2][2], B1[2][2];
  const char* cA = opA(pm, pn); const char* cB = opB(pm, pn);
  S_STAGE(S_SB(0, 0), cB, voffB); S_STAGE(S_SB(0, 1), cB + hstepB, voffB); S_STAGE(S_SA(0, 0), cA, voffA); S_STAGE(S_SA(0, 1), cA + hstepA, voffA);
  if (kwr == 1) S_BAR;
  S_WAIT_V(2); S_BAR;
  S_STAGE(S_SB(1, 0), cB + kstepB, voffB); S_STAGE(S_SA(1, 0), cA + kstepA, voffA); S_STAGE(S_SB(1, 1), cB + hstepB + kstepB, voffB);
  S_WAIT_V(6); S_BAR;
  for (int ui = 0;; ++ui) {
    int pm2 = 0, pn2 = 0; const bool has_next = tile_of(ui + 1, pm2, pn2);
    const char* nA = has_next ? opA(pm2, pn2) : cA; const char* nB = has_next ? opB(pm2, pn2) : cB;
    LAS float* rsl = (LAS float*)(lds + 131072 + (ui & 1) * 1024);
    if (ui == 0 && d.epi != EPI_RESID) { if (ktid < 256) rsl[ktid] = row_rstd(d.P, d.np, d.inv_dim, pm * 256 + ktid); }
    for (int t = 0; t < nt; t += 2) {
      const bool last = (t == nt - 2);
      const char* a1 = cA + (size_t)(t + 1) * kstepA;
      const char* a2 = last ? nA : cA + (size_t)(t + 2) * kstepA; const char* b2 = last ? nB : cB + (size_t)(t + 2) * kstepB;
      const char* a3 = a2 + kstepA; const char* b3 = b2 + kstepB;
      S_LDB(B0, 0, 0); S_LDB(B1, 0, 1); S_SCHED; S_LDA(At, 0, 0); S_STAGE(S_SA(1, 1), a1 + hstepA, voffA);
      S_WAIT_V(8); S_WAIT_L(0); S_BAR; S_MMA(0, 0, At, B0); S_MMA(0, 1, At, B1); S_BAR; S_SCHED;
      S_LDA(At, 0, 1); S_STAGE(S_SB(0, 0), b2, voffB); S_STAGE(S_SB(0, 1), b2 + hstepB, voffB); S_STAGE(S_SA(0, 0), a2, voffA);
      S_WAIT_V(8); S_WAIT_L(0); S_BAR; S_MMA(1, 0, At, B0); S_MMA(1, 1, At, B1); S_BAR; S_SCHED;
      S_LDB(B0, 1, 0); S_LDB(B1, 1, 1); S_SCHED; S_LDA(At, 1, 0); S_STAGE(S_SA(0, 1), a2 + hstepA, voffA);
      S_WAIT_V(8); S_WAIT_L(0); S_BAR; S_MMA(0, 0, At, B0); S_MMA(0, 1, At, B1); S_BAR; S_SCHED;
      S_LDA(At, 1, 1); S_STAGE(S_SB(1, 0), b3, voffB); S_STAGE(S_SB(1, 1), b3 + hstepB, voffB); S_STAGE(S_SA(1, 0), a3, voffA);
      S_WAIT_V(8); S_WAIT_L(0); S_BAR; S_MMA(1, 0, At, B0); S_MMA(1, 1, At, B1); S_BAR; S_SCHED;
    }
    if (kwr == 0) S_BAR;
    const bool nrs = has_next && d.epi != EPI_RESID && ktid < 256;
    float q0 = 0.f, q1 = 0.f, q2 = 0.f, q3 = 0.f;
    if (nrs) { const float* pp = d.P + pm2 * 256 + ktid; q0 = pp[0]; if (d.np > 1) q1 = pp[T]; if (d.np > 2) { q2 = pp[2 * T]; q3 = pp[3 * T]; } }
    {
    const int tid = opaque_tid();
    const int wid = __builtin_amdgcn_readfirstlane(tid >> 6), lane = tid & 63, wr = wid >> 2, wc = wid & 3, fr = lane & 15, fq = lane >> 4;
    const int rb = 64 * wr + fr, cb = d.perm ? 32 * wc + 8 * fq : 32 * wc + 4 * fq, ns = d.perm ? 4 : 16;
    if (EPI_ON(EPI_FFN_UP)) {
#pragma unroll
      for (int ai = 0; ai < 2; ++ai)
#pragma unroll
        for (int m = 0; m < 4; ++m) {
          const int row = pm * 256 + 128 * ai + 16 * m + rb; const float rs = rsl[128 * ai + 16 * m + rb]; const float c1 = -rs * LOG2E, c2 = rs * rs;
          u32x2 hp[2];
#pragma unroll
          for (int n = 0; n < 2; ++n) {
            const f32x4 G = acc[ai][0][m][n], U = acc[ai][1][m][n]; const f32x4 tt = G * c1; f32x4 ee;
#pragma unroll
            for (int j = 0; j < 4; ++j) ee[j] = fexp2(tt[j]);
            const f32x4 dn = ee + 1.f; f32x4 rr;
#pragma unroll
            for (int j = 0; j < 4; ++j) rr[j] = frcp(dn[j]);
            hp[n] = pk4((G * U) * (rr * c2));
          }
          { const int hc = pn * 128 + cb;
            u32x4 hw; hw.x = hp[0].x; hw.y = hp[0].y; hw.z = hp[1].x; hw.w = hp[1].y;
            *(u32x4*)(d.O0 + (size_t)(row >> 8) * (256 * FF) + (size_t)(hc >> 6) * (256 * 64) + (row & 255) * 64 + (hc & 63)) = hw; }
          asm volatile("" ::: "memory");
        }
    } else if (EPI_ON(EPI_RESID)) {
      LAS float* red = (LAS float*)(lds + 133120); const float alpha = d.K == FF ? 0.5f : 1.f;
#pragma unroll
      for (int ai = 0; ai < 2; ++ai)
#pragma unroll
        for (int m = 0; m < 4; ++m) {
          const int row = pm * 256 + 128 * ai + 16 * m + rb; float ss = 0.f;
#pragma unroll
          for (int bj = 0; bj < 2; ++bj) {
            const size_t o = (size_t)row * DM + pn * 256 + 128 * bj + cb;
            const u32x4 xw = *(const u32x4*)(d.O0 + o); u32x4 ow;
#pragma unroll
            for (int n = 0; n < 2; ++n) {
              const unsigned w0 = n ? xw.z : xw.x, w1 = n ? xw.w : xw.y;
              f32x4 xo; xo[0] = __uint_as_float(w0 << 16); xo[1] = __uint_as_float(w0 & 0xffff0000u); xo[2] = __uint_as_float(w1 << 16); xo[3] = __uint_as_float(w1 & 0xffff0000u);
              const f32x4 xn = xo + acc[ai][bj][m][n] * alpha;
              ss += (xn[0] * xn[0] + xn[1] * xn[1]) + (xn[2] * xn[2] + xn[3] * xn[3]);
              const u32x2 pw = pk4(xn); if (n) { ow.z = pw.x; ow.w = pw.y; } else { ow.x = pw.x; ow.y = pw.y; }
            }
            *(u32x4*)(d.O0 + o) = ow;
          }
          ss += __shfl_xor(ss, 16); ss += __shfl_xor(ss, 32);
          if (fq == 0) red[wc * 256 + 128 * ai + 16 * m + rb] = ss;
          asm volatile("" ::: "memory");
        }
      G_LBAR;
      if (tid < 256) d.Pout[(size_t)pn * T + pm * 256 + tid] = (red[tid] + red[256 + tid]) + (red[512 + tid] + red[768 + tid]);
      G_LBAR;
    } else if (EPI_ON(EPI_MLA_C)) {
      if (pn < 3) {
        LAS float* red = (LAS float*)(lds + 133120);
#pragma unroll
        for (int ai = 0; ai < 2; ++ai)
#pragma unroll
          for (int m = 0; m < 4; ++m) {
            const int row = pm * 256 + 128 * ai + 16 * m + rb; const float rs = rsl[128 * ai + 16 * m + rb]; float ss = 0.f;
#pragma unroll
            for (int bj = 0; bj < 2; ++bj) {
              const f32x4 v0 = acc[ai][bj][m][0] * rs, v1 = acc[ai][bj][m][1] * rs;
              ss += ((v0[0] * v0[0] + v0[1] * v0[1]) + (v0[2] * v0[2] + v0[3] * v0[3])) + ((v1[0] * v1[0] + v1[1] * v1[1]) + (v1[2] * v1[2] + v1[3] * v1[3]));
              const u32x2 w0 = pk4(v0), w1 = pk4(v1); u32x4 ww; ww.x = w0.x; ww.y = w0.y; ww.z = w1.x; ww.w = w1.y;
              *(u32x4*)(d.O0 + (size_t)row * DM + pn * 256 + 128 * bj + cb) = ww;
            }
            ss += __shfl_xor(ss, 16); ss += __shfl_xor(ss, 32);
            if (fq == 0) red[wc * 256 + 128 * ai + 16 * m + rb] = ss;
            asm volatile("" ::: "memory");
          }
        G_LBAR;
        float* dst = pn < 2 ? d.Pout + (size_t)pn * T : d.Pout2;
        if (tid < 256) dst[pm * 256 + tid] = (red[tid] + red[256 + tid]) + (red[512 + tid] + red[768 + tid]);
        G_LBAR;
      } else if (wc == 0) {
#pragma unroll
        for (int ai = 0; ai < 2; ++ai)
#pragma unroll
          for (int m = 0; m < 4; ++m) {
            const int row = pm * 256 + 128 * ai + 16 * m + rb; const float rs = rsl[128 * ai + 16 * m + rb];
            int tb, L, pos; tok_info(row, tb, L, pos);
            const f32x4 cs = *(const f32x4*)(d.rope + pos * 16 + 4 * fq), sn = *(const f32x4*)(d.rope + 8192 * 16 + pos * 16 + 4 * fq);
            const f32x4 x1 = acc[ai][0][m][0] * rs, x2 = acc[ai][0][m][1] * rs;
            const u32x2 r1 = pk4(x1 * cs - x2 * sn), r2 = pk4(x1 * sn + x2 * cs);
            bf16_t* kp = d.O1 + (size_t)row * 1536 + 64 + 4 * fq;
#pragma unroll
            for (int hd = 0; hd < 16; ++hd) { *(u32x2*)(kp + hd * 96) = r1; *(u32x2*)(kp + hd * 96 + 16) = r2; }
            asm volatile("" ::: "memory");
          }
      }
    } else if (EPI_ON(EPI_MLA_Q)) {
#pragma unroll
      for (int ai = 0; ai < 2; ++ai)
#pragma unroll
        for (int m = 0; m < 4; ++m) {
          const int row = pm * 256 + 128 * ai + 16 * m + rb; const float rs = rsl[128 * ai + 16 * m + rb];
          int tb, L, pos; tok_info(row, tb, L, pos);
          const f32x4 cs = *(const f32x4*)(d.rope + pos * 16 + 4 * fq), sn = *(const f32x4*)(d.rope + 8192 * 16 + pos * 16 + 4 * fq);
#pragma unroll
          for (int bj = 0; bj < 2; ++bj) {
            const int g32 = pn * 8 + 4 * bj + wc;
            f32x4 v0 = acc[ai][bj][m][0] * rs, v1 = acc[ai][bj][m][1] * rs;
            bf16_t* gp = d.O0 + (size_t)row * 1536 + pn * 256 + 128 * bj + 32 * wc;
            if (g32 % 3 == 2) {
              const f32x4 t0 = v0 * cs - v1 * sn, t1 = v0 * sn + v1 * cs;
              *(u32x2*)(gp + 4 * fq) = pk4(t0); *(u32x2*)(gp + 16 + 4 * fq) = pk4(t1);
            } else {
              const u32x2 w0 = pk4(v0), w1 = pk4(v1); u32x4 ww; ww.x = w0.x; ww.y = w0.y; ww.z = w1.x; ww.w = w1.y; *(u32x4*)(gp + 8 * fq) = ww;
            }
          }
          asm volatile("" ::: "memory");
        }
    } else if (EPI_ON(EPI_KV)) {
      if (!sw) {
#pragma unroll
        for (int ai = 0; ai < 2; ++ai)
#pragma unroll
          for (int m = 0; m < 4; ++m) {
            const int row = pm * 256 + 128 * ai + 16 * m + rb; const float rs = rsl[128 * ai + 16 * m + rb];
#pragma unroll
            for (int bj = 0; bj < 2; ++bj) {
              const int col = pn * 256 + 128 * bj + cb;
              bf16_t* dst;
              if (d.kmode == 0) dst = d.O0 + (size_t)row * 1536 + (col >> 6) * 96 + (col & 63);
              else dst = (pn < 4 ? d.O0 : d.O1) + (size_t)row * DM + (col & 1023);
              const u32x2 w0 = pk4(acc[ai][bj][m][0] * rs), w1 = pk4(acc[ai][bj][m][1] * rs);
              u32x4 ww; ww.x = w0.x; ww.y = w0.y; ww.z = w1.x; ww.w = w1.y; *(u32x4*)dst = ww;
            }
            asm volatile("" ::: "memory");
          }
      } else {
        int tb, L, pos; tok_info(pm * 256, tb, L, pos);
        f32x4 rs4[2][2];
#pragma unroll
        for (int bj = 0; bj < 2; ++bj)
#pragma unroll
          for (int n = 0; n < 2; ++n)
#pragma unroll
            for (int j = 0; j < 4; ++j) rs4[bj][n][j] = rsl[128 * bj + ns * n + cb + j];
#pragma unroll
        for (int ai = 0; ai < 2; ++ai)
#pragma unroll
          for (int m = 0; m < 4; ++m) {
            const int wcol = (pn - d.vpn) * 256 + 128 * ai + 16 * m + rb;
            bf16_t* vp = d.O2 + (size_t)tb * DM + (size_t)wcol * L;
#pragma unroll
            for (int bj = 0; bj < 2; ++bj) {
              const u32x2 w0 = pk4(acc[ai][bj][m][0] * rs4[bj][0]), w1 = pk4(acc[ai][bj][m][1] * rs4[bj][1]);
              u32x4 ww; ww.x = w0.x; ww.y = w0.y; ww.z = w1.x; ww.w = w1.y; *(u32x4*)(vp + ((pos + 128 * bj + cb + 64 * wcol) & (L - 1))) = ww;
            }
            asm volatile("" ::: "memory");
          }
      }
    }
    }
    if (nrs) ((LAS float*)(lds + 131072 + ((ui + 1) & 1) * 1024))[ktid] = rsqrtf(((q0 + q1) + (q2 + q3)) * d.inv_dim + EPS);
    if (!has_next) break;
#pragma unroll
    for (int a = 0; a < 2; ++a)
#pragma unroll
      for (int b = 0; b < 2; ++b)
#pragma unroll
        for (int m = 0; m < 4; ++m)
#pragma unroll
          for (int n = 0; n < 2; ++n) acc[a][b][m][n] = (f32x4){0.f, 0.f, 0.f, 0.f};
    pm = pm2; pn = pn2; cA = nA; cB = nB;
    if (kwr == 1) S_BAR;
  }
  S_WAIT_V(0);
  S_BAR;
#undef S_SA
#undef S_SB
#undef S_STAGE
#undef S_LDA
#undef S_LDB
#undef S_MMA
#undef S_WAIT_V
#undef S_WAIT_L
#undef S_BAR
#undef S_SCHED
}

DI void conv_block(const float* src, int ld, int scol0, bf16_t* dst, int K, int drow0, int k0, const float* gain, float scale, LAS float* scr, int lane, bool rperm = false) {
  if (src) {
    const int l31 = lane & 31, scl = rperm ? (((l31 >> 3) << 2) + (l31 & 3) + (((l31 >> 2) & 1) << 4)) : l31;
    float tmp[32];
#pragma unroll
    for (int i = 0; i < 32; ++i) { const int kk = 2 * i + (lane >> 5); tmp[i] = __builtin_nontemporal_load(src + (size_t)(k0 + kk) * ld + scol0 + scl); }
#pragma unroll
    for (int i = 0; i < 32; ++i) { const int kk = 2 * i + (lane >> 5); scr[kk * 33 + (lane & 31)] = tmp[i]; }
  } else {
#pragma unroll 8
    for (int i = 0; i < 32; ++i) { const int kk = 2 * i + (lane >> 5); scr[kk * 33 + (lane & 31)] = 0.f; }
  }
  asm volatile("s_waitcnt vmcnt(0) lgkmcnt(0)" ::: "memory"); __builtin_amdgcn_wave_barrier();
  const int c = lane & 7;
  float g[8];
#pragma unroll
  for (int e = 0; e < 8; ++e) g[e] = (gain ? gain[k0 + 8 * c + e] : 1.f) * scale;
#pragma unroll
  for (int j = 0; j < 4; ++j) {
    const int n = (lane >> 3) + 8 * j; const LAS float* s = scr + (8 * c) * 33 + n;
    u32x4 o; o.x = cvt_pk(s[0] * g[0], s[33] * g[1]); o.y = cvt_pk(s[66] * g[2], s[99] * g[3]); o.z = cvt_pk(s[132] * g[4], s[165] * g[5]); o.w = cvt_pk(s[198] * g[6], s[231] * g[7]);
    *(u32x4*)(dst + (size_t)(drow0 + n) * K + k0 + 8 * c) = o;
  }
  asm volatile("s_waitcnt lgkmcnt(0)" ::: "memory"); __builtin_amdgcn_wave_barrier();
}
DI void conv_job(const float* src, int ld, int scol0, bf16_t* dst, int K, int drow0, int nrows, const float* gain, float scale, LAS float* scr, int gw, int ngw, int lane, int rmode = 0) {
  const int nkb = K / 64, nblk = nrows / 32, items = nkb * nblk;
  for (int it = gw; it < items; it += ngw) { const int nb = it / nkb, kb = it % nkb; const bool rp = rmode == 1 ? (nb % 3 == 2) : (rmode == 2 ? nb == nblk - 1 : false);
    conv_block(src, ld, scol0 + 32 * nb, dst, K, drow0 + 32 * nb, 64 * kb, gain, scale, scr, lane, rp); }
}
DI void conv_gu(const float* wg, const float* wu, bf16_t* dst, const float* gain, LAS float* scr, int gw, int ngw, int lane) {
  const int nkb = 16, items = nkb * (5632 / 32);
  for (int it = gw; it < items; it += ngw) {
    const int nb = it / nkb, kb = it % nkb, row0 = 32 * nb, pn = row0 >> 8, wi = row0 & 255;
    const float* src = wi < 128 ? wg : wu; const int scol = pn * 128 + (wi & 127);
    conv_block(src, FF, scol, dst, 1024, row0, 64 * kb, gain, 1.f, scr, lane);
  }
}

DI void sincos_f(float a, float& s, float& c) {
  const float kq = rintf(a * 0.636619772f);
  float y = fmaf(-kq, 1.57079637e+00f, a); y = fmaf(-kq, -4.37113883e-08f, y);
  const float y2 = y * y;
  const float sp = y + y * y2 * (-1.66666667e-01f + y2 * (8.33333333e-03f + y2 * (-1.98412698e-04f + y2 * 2.75573192e-06f)));
  const float cp = 1.f + y2 * (-0.5f + y2 * (4.16666667e-02f + y2 * (-1.38888889e-03f + y2 * (2.48015873e-05f + y2 * -2.75573192e-07f))));
  const int q = ((int)kq) & 3;
  float ss = (q & 1) ? cp : sp, cc = (q & 1) ? sp : cp;
  if (q == 1) cc = -cc; else if (q == 2) { ss = -ss; cc = -cc; } else if (q == 3) ss = -ss;
  s = ss; c = cc;
}

struct ConvItem { const float* src; int ld; int scol; bf16_t* dst; int K; int drow; int k0; const float* gain; float scale; bool rp; };
DI void conv_load(const ConvItem& c, int lane, float (&tmp)[32], f32x4 (&g)[2]) {
  const int l31 = lane & 31, scl = c.rp ? (((l31 >> 3) << 2) + (l31 & 3) + (((l31 >> 2) & 1) << 4)) : l31;
  if (c.src) {
#pragma unroll
    for (int i = 0; i < 32; ++i) { const int kk = 2 * i + (lane >> 5); tmp[i] = __builtin_nontemporal_load(c.src + (size_t)(c.k0 + kk) * c.ld + c.scol + scl); }
  } else {
#pragma unroll
    for (int i = 0; i < 32; ++i) tmp[i] = 0.f;
  }
  if (c.gain) { const f32x4* gp = (const f32x4*)(c.gain + c.k0 + 8 * (lane & 7)); g[0] = gp[0]; g[1] = gp[1]; }
  else { g[0] = (f32x4){1.f, 1.f, 1.f, 1.f}; g[1] = g[0]; }
}
DI void conv_proc(const ConvItem& c, int lane, const float (&tmp)[32], const f32x4 (&g)[2], LAS float* scr) {
#pragma unroll
  for (int i = 0; i < 32; ++i) { const int kk = 2 * i + (lane >> 5); scr[kk * 33 + (lane & 31)] = tmp[i]; }
  asm volatile("s_waitcnt lgkmcnt(0)" ::: "memory"); __builtin_amdgcn_wave_barrier();
  const int cc = lane & 7; const f32x4 g0 = g[0] * c.scale, g1 = g[1] * c.scale;
#pragma unroll
  for (int j = 0; j < 4; ++j) {
    const int n = (lane >> 3) + 8 * j; const LAS float* sp = scr + (8 * cc) * 33 + n;
    u32x4 o; o.x = cvt_pk(sp[0] * g0[0], sp[33] * g0[1]); o.y = cvt_pk(sp[66] * g0[2], sp[99] * g0[3]); o.z = cvt_pk(sp[132] * g1[0], sp[165] * g1[1]); o.w = cvt_pk(sp[198] * g1[2], sp[231] * g1[3]);
    *(u32x4*)(c.dst + (size_t)(c.drow + n) * c.K + c.k0 + 8 * cc) = o;
  }
  asm volatile("s_waitcnt lgkmcnt(0)" ::: "memory"); __builtin_amdgcn_wave_barrier();
}

DI void conv_phase(KP p, int layer, LAS unsigned char* lds) {
  const int tid = opaque_tid(), wid = tid >> 6, lane = tid & 63;
  LAS float* scr = (LAS float*)(lds + wid * 8448);
  const int gw = blockIdx.x * 8 + wid, ngw = gridDim.x * 8;
  unsigned char* ws = p->ws;
  const float* ng = p->in[2] + (size_t)layer * 3 * DM;
  bf16_t* WM = (bf16_t*)(ws + OFF_W + W_MIX);
  const int mx = layer % 3, j = layer / 3;
  const float* g1 = ng + DM;
  auto decode = [&](int f, ConvItem& c) __attribute__((always_inline)) -> bool {
    int r = f; c.scale = 1.f; c.rp = false; c.gain = nullptr;
#define CJ_PLAIN(SRC, LD, SCOL0, DST, KK, DROW0, NROWS, GAIN, SCALE, RMODE) { const int nkb_ = (KK) / 64, nblk_ = (NROWS) / 32, items_ = nkb_ * nblk_; \
      if (r < items_) { const int nb_ = r % nblk_, kb_ = r / nblk_; c.src = (SRC);     c.ld = (LD); c.scol = (SCOL0) + 32 * nb_; c.dst = (DST); c.K = (KK); c.drow = (DROW0) + 32 * nb_; c.k0 = 64 * kb_; \
        c.gain = (GAIN); c.scale = (SCALE); c.rp = (RMODE) == 1 ? (nb_ % 3 == 2) : ((RMODE) == 2 ? nb_ == nblk_ - 1 : false); return true; } r -= items_; }
    for (int s2 = 0; s2 < 2; ++s2) {
      const size_t wo_ = ((size_t)layer * 2 + s2) * DM * FF;
      { const int items_ = 16 * (5632 / 32);
        if (r < items_) { const int nb_ = r % 176, kb_ = r / 176, row0 = 32 * nb_, pn_ = row0 >> 8, wi = row0 & 255;
          c.src = (wi < 128 ? p->in[4] : p->in[5]) + wo_; c.ld = FF; c.scol = pn_ * 128 + (wi & 127); c.dst = (bf16_t*)(ws + OFF_W + (s2 ? W_GU1 : W_GU0)); c.K = 1024; c.drow = row0; c.k0 = 64 * kb_;
          c.gain = ng + (s2 ? 2 * DM : 0); return true; } r -= items_; }
      CJ_PLAIN(p->in[6] + wo_, DM, 0, (bf16_t*)(ws + OFF_W + (s2 ? W_DN1 : W_DN0)), FF, 0, DM, (const float*)nullptr, 1.f, 0)
    }
    if (mx == 0) {
      bf16_t* wc_ = WM; bf16_t* wq = wc_ + 1024 * 1024; bf16_t* wkv = wq + 1536 * 512; bf16_t* wo = wkv + 2048 * 256;
      CJ_PLAIN(p->in[8] + (size_t)j * 1024 * 512, 512, 0, wc_, 1024, 0, 512, g1, 1.f, 0)
      CJ_PLAIN(p->in[11] + (size_t)j * 1024 * 288, 288, 0, wc_, 1024, 512, 288, g1, 1.f, 2)
      CJ_PLAIN((const float*)nullptr, 0, 0, wc_, 1024, 800, 224, (const float*)nullptr, 1.f, 0)
      CJ_PLAIN(p->in[10] + (size_t)j * 512 * 1536, 1536, 0, wq, 512, 0, 1536, p->in[9] + j * 512, 0.10206207261596575f * LOG2E, 1)
      CJ_PLAIN(p->in[13] + (size_t)j * 256 * 1024, 1024, 0, wkv, 256, 0, 1024, p->in[12] + j * 256, 1.f, 0)
      CJ_PLAIN(p->in[14] + (size_t)j * 256 * 1024, 1024, 0, wkv, 256, 1024, 1024, p->in[12] + j * 256, 1.f, 0)
      CJ_PLAIN(p->in[15] + (size_t)j * 1024 * 1024, 1024, 0, wo, 1024, 0, 1024, (const float*)nullptr, 1.f, 0)
    } else if (mx == 1) {
      bf16_t* wqkv = WM; bf16_t* wo = wqkv + 3072 * 1024;
      CJ_PLAIN(p->in[16], 1024, 0, wqkv, 1024, 0, 1024, g1, 0.125f * LOG2E, 0)
      CJ_PLAIN(p->in[17], 1024, 0, wqkv, 1024, 1024, 1024, g1, 1.f, 0)
      CJ_PLAIN(p->in[18], 1024, 0, wqkv, 1024, 2048, 1024, g1, 1.f, 0)
      CJ_PLAIN(p->in[24], 1024, 0, wo, 1024, 0, 1024, (const float*)nullptr, 1.f, 0)
    } else {
      bf16_t* wqkv = WM; bf16_t* wo = wqkv + 3072 * 1024;
      CJ_PLAIN(p->in[25], 3072, 0, wqkv, 1024, 0, 1024, g1, 0.125f * LOG2E, 0)
      CJ_PLAIN(p->in[25], 3072, 1024, wqkv, 1024, 1024, 2048, g1, 1.f, 0)
      CJ_PLAIN(p->in[27], 1024, 0, wo, 1024, 0, 1024, (const float*)nullptr, 1.f, 0)
    }
#undef CJ_PLAIN
    return false;
  };
  {
    ConvItem cur, nxt; float ta[32], tb[32]; f32x4 ga[2], gb[2];
    bool v = decode(gw, cur);
    if (v) conv_load(cur, lane, ta, ga);
    for (int f = gw; v;) {
      const int fn = f + ngw; const bool vn = decode(fn, nxt);
      if (vn) conv_load(nxt, lane, tb, gb);
      conv_proc(cur, lane, ta, ga, scr);
      cur = nxt;
#pragma unroll
      for (int i = 0; i < 32; ++i) ta[i] = tb[i];
      ga[0] = gb[0]; ga[1] = gb[1]; v = vn; f = fn;
    }
  }
  if (layer == 0) {
    bf16_t* XB = (bf16_t*)(ws + OFF_XR); float* P4 = (float*)(ws + OFF_P4);
    for (int row = gw; row < T; row += ngw) {
      const float* xr = row < 16384 ? p->in[0] + (size_t)row * DM : p->in[1] + (size_t)(row - 16384) * DM;
      float ss = 0.f;
#pragma unroll
      for (int q = 0; q < 4; ++q) {
        const f32x4 v = *(const f32x4*)(xr + 256 * q + 4 * lane);
        *(u32x2*)(XB + (size_t)row * DM + 256 * q + 4 * lane) = pk4(v);
        ss += (v[0] * v[0] + v[1] * v[1]) + (v[2] * v[2] + v[3] * v[3]);
      }
#pragma unroll
      for (int o = 1; o < 64; o <<= 1) ss += __shfl_xor(ss, o);
      if (lane < 4) P4[(size_t)lane * T + row] = lane == 0 ? ss : 0.f;
    }
    float* rope = (float*)(ws + OFF_ROPE);
    for (int e = blockIdx.x * 512 + tid; e < 8192 * 16; e += gridDim.x * 512) {
      const int pos = e >> 4, dd = e & 15; float s, c; sincos_f((float)pos * FREQ[dd], s, c);
      rope[e] = c; rope[8192 * 16 + e] = s;
    }
  }
}

constexpr int ATT_KB = 0, ATT_VB = 53248, ATT_LUT = 126976;
DI int crow(int reg, int h) { return (reg & 3) + 8 * (reg >> 2) + 4 * h; }

typedef float f32x2v __attribute__((ext_vector_type(2)));
constexpr float ATT_THR = 8.f;

template <int DK, int DV, int MODE>
DI void flash_pass(LAS unsigned char* lds, const bf16_t* Qw, int ldq, const bf16_t* Kb, int ldk, const bf16_t* Vseq, int c0, int kv0, int L, int ntiles,
                   int rel0, const LAS float* lut, int ka0, int ri, int rs_w, int cw, f32x16 (&O)[DV / 32], float& ltot) {
  constexpr int KSTR = DK * 2 + 16, KBUF = 64 * KSTR, VSTR = 144, VBUF = DV * VSTR, KC8 = DK / 8, NKC = 64 * KC8, KI = (NKC + 511) / 512, VI = DV * 8 / 512;
  const int tid = opaque_tid(), lane = tid & 63, r = lane & 31, hh = lane >> 5;
#define FA_BAR do { asm volatile("s_waitcnt lgkmcnt(0)" ::: "memory"); __builtin_amdgcn_s_barrier(); asm volatile("" ::: "memory"); } while (0)
  bf16x8 qf[DK / 16];
#pragma unroll
  for (int kk = 0; kk < DK / 16; ++kk) qf[kk] = *(const bf16x8*)(Qw + (size_t)r * ldq + 16 * kk + 8 * hh);
#pragma unroll
  for (int db = 0; db < DV / 32; ++db)
#pragma unroll
    for (int i = 0; i < 16; ++i) O[db][i] = 0.f;
  float mrun = -INFINITY, lsum = 0.f;
  unsigned nacolp[8];
  if (MODE == 1) {
    const int c = cw + r; int cs = c - 8; cs = cs < 0 ? 0 : (cs > 48 ? 48 : cs);
#pragma unroll
    for (int q = 0; q < 8; ++q) { unsigned wv = 0;
#pragma unroll
      for (int b4 = 0; b4 < 4; ++b4) { const int j = 4 * q + b4, kb = j >> 4, i = j & 15; const int e = 32 * kb + (i & 3) + 8 * (i >> 2) + 4 * hh; const bool valid = (e >= cs) && (e < cs + 16);
        wv |= (unsigned)(valid ? (e - c + 15) * 4 : 31 * 4) << (8 * b4); }
      nacolp[q] = wv; }
  }
  u32x4 kr[KI], vr[VI];
  int krow_[KI], kc8_[KI];
#pragma unroll
  for (int i = 0; i < KI; ++i) { const int c = tid + 512 * i; krow_[i] = c / KC8; kc8_[i] = c % KC8; }
#define FA_LOADK(t) do { _Pragma("unroll") for (int i = 0; i < KI; ++i) if (tid + 512 * i < NKC) kr[i] = *(const u32x4*)(Kb + (size_t)((t) * 64 + krow_[i]) * ldk + kc8_[i] * 8); } while (0)
#define FA_LOADV(t) do { _Pragma("unroll") for (int i = 0; i < VI; ++i) { const int c = tid + 512 * i, cg_ = c0 + (c >> 3); vr[i] = *(const u32x4*)(Vseq + (size_t)cg_ * L + ((kv0 + 64 * ((t) + cg_)) & (L - 1)) + (c & 7) * 8); } } while (0)
#define FA_STOREK(b) do { _Pragma("unroll") for (int i = 0; i < KI; ++i) if (tid + 512 * i < NKC) *(LAS u32x4*)(lds + ATT_KB + (b) * KBUF + krow_[i] * KSTR + kc8_[i] * 16) = kr[i]; } while (0)
#define FA_STOREV(b) do { _Pragma("unroll") for (int i = 0; i < VI; ++i) { const int c = tid + 512 * i; LAS unsigned char* vp_ = lds + ATT_VB + (b) * VBUF + (c >> 3) * VSTR + ((c & 7) >> 1) * 32 + (c & 1) * 8; \
    u32x2 lo_, hi_; lo_.x = vr[i].x; lo_.y = vr[i].y; hi_.x = vr[i].z; hi_.y = vr[i].w; *(LAS u32x2*)vp_ = lo_; *(LAS u32x2*)(vp_ + 16) = hi_; } } while (0)
#define FA_SCORE(dst, bvar, tt) do { float cadd_ = 0.f; if (MODE == 0) { const int d0_ = rel0 + 64 * (tt); cadd_ = (d0_ - 31 >= 91) ? cpos : ((d0_ + 63 <= -91) ? cneg : 0.f); }     \
      const float mb_ = (mrun == -INFINITY) ? 0.f : mrun; bvar = mb_; const float init_ = cadd_ - mb_;     \
      _Pragma("unroll") for (int kb = 0; kb < 2; ++kb) { bf16x8 kf_[DK / 16]; \
      _Pragma("unroll") for (int kk = 0; kk < DK / 16; ++kk) \
        kf_[kk] = *(const LAS bf16x8*)(lds + ATT_KB + ((tt) & 3) * KBUF + (32 * kb + r) * KSTR + (16 * kk + 8 * hh) * 2); \
      _Pragma("unroll") for (int i = 0; i < 16; ++i) dst[kb][i] = init_; \
      _Pragma("unroll") for (int kk = 0; kk < DK / 16; ++kk) dst[kb] = __builtin_amdgcn_mfma_f32_32x32x16_bf16(kf_[kk], qf[kk], dst[kb], 0, 0, 0); } } while (0)
  auto part1 = [&](f32x16 (&st)[2], float mbase, int t) __attribute__((always_inline)) {
    if (MODE == 0) {
      const int d0 = rel0 + 64 * t;
      if (!(d0 - 31 >= 91) && !(d0 + 63 <= -91)) {
        const int rb_ = d0 - r + 4 * hh + 128;
#pragma unroll
        for (int kb = 0; kb < 2; ++kb)
#pragma unroll
          for (int i = 0; i < 16; ++i) { int idx = rb_ + 32 * kb + (i & 3) + 8 * (i >> 2); idx = idx < 0 ? 0 : (idx > 256 ? 256 : idx); st[kb][i] += lut[idx]; }
      }
    } else {
      const int ka = ka0 + t;
      const LAS unsigned char* rp = (const LAS unsigned char*)lut + (ka - ri + 7) * 128;
#pragma unroll
      for (int q = 0; q < 8; ++q) { unsigned wv = nacolp[q]; asm volatile("" : "+v"(wv));
#pragma unroll
        for (int b4 = 0; b4 < 4; ++b4) { const int j = 4 * q + b4; st[j >> 4][j & 15] += *(const LAS float*)(rp + ((wv >> (8 * b4)) & 0xffu)); } }
    }
    float mx = fmaxf(st[0][0], st[1][0]);
#pragma unroll
    for (int i = 1; i < 16; ++i) mx = fmaxf(fmaxf(mx, st[0][i]), st[1][i]);
    mx = fmaxf(mx, __shfl_xor(mx, 32));
    const float mabs = mx + mbase;
    if (__any(mabs > mrun + ATT_THR)) {
      const float mn = fmaxf(mrun, mabs), alpha = fexp2(mrun - mn); mrun = mn; lsum *= alpha;
#pragma unroll
      for (int db = 0; db < DV / 32; ++db)
#pragma unroll
        for (int i = 0; i < 16; ++i) O[db][i] *= alpha;
    }
    const float delta = mrun - mbase;
    if (__any(delta != 0.f)) {
#pragma unroll
      for (int kb = 0; kb < 2; ++kb)
#pragma unroll
        for (int i = 0; i < 16; ++i) st[kb][i] -= delta;
    }
  };
  auto part2 = [&](f32x16 (&st)[2], int t) __attribute__((always_inline)) {
    float ps0 = 0.f, ps1 = 0.f, ps2 = 0.f, ps3 = 0.f;
#pragma unroll
    for (int kb = 0; kb < 2; ++kb)
#pragma unroll
      for (int i = 0; i < 16; i += 4) {
        const float p0 = fexp2(st[kb][i]), p1 = fexp2(st[kb][i + 1]), p2 = fexp2(st[kb][i + 2]), p3 = fexp2(st[kb][i + 3]);
        st[kb][i] = p0; st[kb][i + 1] = p1; st[kb][i + 2] = p2; st[kb][i + 3] = p3; ps0 += p0; ps1 += p1; ps2 += p2; ps3 += p3;
      }
    lsum += (ps0 + ps1) + (ps2 + ps3);
    bf16x8 pf[2][2];
#pragma unroll
    for (int kb = 0; kb < 2; ++kb)
#pragma unroll
      for (int s = 0; s < 2; ++s) { u32x4 pp; pp.x = cvt_pk(st[kb][8 * s], st[kb][8 * s + 1]); pp.y = cvt_pk(st[kb][8 * s + 2], st[kb][8 * s + 3]); pp.z = cvt_pk(st[kb][8 * s + 4], st[kb][8 * s + 5]); pp.w = cvt_pk(st[kb][8 * s + 6], st[kb][8 * s + 7]); pf[kb][s] = __builtin_bit_cast(bf16x8, pp); }
#pragma unroll
    for (int db = 0; db < DV / 32; ++db)
#pragma unroll
      for (int kb = 0; kb < 2; ++kb)
#pragma unroll
        for (int s = 0; s < 2; ++s) {
          const bf16x8 vf = *(const LAS bf16x8*)(lds + ATT_VB + (t & 3) * VBUF + (32 * db + r) * VSTR + (2 * kb + s) * 32 + hh * 16);
          O[db] = __builtin_amdgcn_mfma_f32_32x32x16_bf16(vf, pf[kb][s], O[db], 0, 0, 0);
        }
  };
#define FA_STEP(t, cur, bcur, nxt, bnxt, DOBAR) do { \
    FA_STOREK(((t) + 3) & 3); FA_STOREV(((t) + 2) & 3); \
    FA_LOADK(((t) + 4 < ntiles) ? (t) + 4 : ntiles - 1); FA_LOADV(((t) + 3 < ntiles) ? (t) + 3 : ntiles - 1); \
    bool act_ = true; if (MODE == 1) { const int ka_ = ka0 + (t); act_ = (ka_ >= rs_w) && (ka_ < rs_w + 8); } \
    if (act_) part1(cur, bcur, (t)); \
    __builtin_amdgcn_s_setprio(1);     \
    FA_SCORE(nxt, bnxt, (t) + 1); \
    if (act_) part2(cur, (t)); \
    __builtin_amdgcn_s_setprio(0); \
    if (DOBAR) FA_BAR; } while (0)
  f32x16 stA[2], stB[2]; float baseA = 0.f, baseB = 0.f;
  {
    u32x4 kr1[KI], kr2[KI], vr1[VI]; const int t1_ = ntiles > 1 ? 1 : 0, t2_ = ntiles > 2 ? 2 : ntiles - 1;
    FA_LOADK(0); FA_LOADV(0);
#pragma unroll
    for (int i = 0; i < KI; ++i) if (tid + 512 * i < NKC) { kr1[i] = *(const u32x4*)(Kb + (size_t)(t1_ * 64 + krow_[i]) * ldk + kc8_[i] * 8); kr2[i] = *(const u32x4*)(Kb + (size_t)(t2_ * 64 + krow_[i]) * ldk + kc8_[i] * 8); }
#pragma unroll
    for (int i = 0; i < VI; ++i) { const int c = tid + 512 * i, cg_ = c0 + (c >> 3); vr1[i] = *(const u32x4*)(Vseq + (size_t)cg_ * L + ((kv0 + 64 * (t1_ + cg_)) & (L - 1)) + (c & 7) * 8); }
    FA_STOREK(0); FA_STOREV(0);
#pragma unroll
    for (int i = 0; i < KI; ++i) if (tid + 512 * i < NKC) { *(LAS u32x4*)(lds + ATT_KB + KBUF + krow_[i] * KSTR + kc8_[i] * 16) = kr1[i]; *(LAS u32x4*)(lds + ATT_KB + 2 * KBUF + krow_[i] * KSTR + kc8_[i] * 16) = kr2[i]; }
#pragma unroll
    for (int i = 0; i < VI; ++i) { const int c = tid + 512 * i; LAS unsigned char* vp_ = lds + ATT_VB + VBUF + (c >> 3) * VSTR + ((c & 7) >> 1) * 32 + (c & 1) * 8;
      u32x2 lo_, hi_; lo_.x = vr1[i].x; lo_.y = vr1[i].y; hi_.x = vr1[i].z; hi_.y = vr1[i].w; *(LAS u32x2*)vp_ = lo_; *(LAS u32x2*)(vp_ + 16) = hi_; }
  }
  FA_LOADK(ntiles > 3 ? 3 : ntiles - 1);
  FA_LOADV(ntiles > 2 ? 2 : ntiles - 1);
  FA_BAR;
  float cpos = 0.f, cneg = 0.f; if (MODE == 0) { cpos = lut[256]; cneg = lut[0]; }
  FA_SCORE(stA, baseA, 0);
  for (int t = 0; t < ntiles; t += 2) {
    FA_STEP(t, stA, baseA, stB, baseB, false);
    if (t + 1 < ntiles) FA_STEP(t + 1, stB, baseB, stA, baseA, true);
  }
  FA_BAR;
  ltot = lsum + __shfl_xor(lsum, 32);
#undef FA_LOADK
#undef FA_LOADV
#undef FA_STOREK
#undef FA_STOREV
#undef FA_SCORE
#undef FA_STEP
#undef FA_BAR
}

DI void unit_map(int idx, int nheads, int& tb, int& L, int& head, int& qb) {
  const int nS = 2 * nheads * 32;
  int g;
  if (idx < nS) { const int round = idx >> 8, blk = idx & 255; g = round * 8 + (blk & 7); qb = blk >> 3; L = 8192; const int seq = g / nheads; head = g % nheads; tb = 16384 + seq * 8192; }
  else { const int i2 = idx - nS; const int round = i2 >> 8, blk = i2 & 255; g = round * 32 + (blk & 7) * 4 + ((blk >> 3) >> 3); qb = (blk >> 3) & 7; L = 2048; const int seq = g / nheads; head = g % nheads; tb = seq * 2048; }
}
DI void t5_lut(LAS float* lut, const float* table, int head, int tid) {
  if (tid < 257) { const int rel = tid - 128, n = rel < 0 ? -rel : rel; int b = n; if (n >= 8) { b = 8 + (31 - __clz(n * n)) - 6; if (b > 15) b = 15; }
    lut[tid] = table[((rel > 0 ? 16 : 0) + b) * 16 + head] * LOG2E; }
}

DI void att_mla_phase(KP p, LAS unsigned char* lds) {
  const int tid = opaque_tid(), w = tid >> 6, lane = tid & 63, r = lane & 31, hh = lane >> 5;
  const bf16_t* Q = (const bf16_t*)(p->ws + OFF_BIG + 64 * MiB); const bf16_t* Kf = (const bf16_t*)(p->ws + OFF_BIG + 160 * MiB);
  const bf16_t* Vt = (const bf16_t*)(p->ws + OFF_A); bf16_t* Oo = (bf16_t*)(p->ws + OFF_BIG);
  LAS float* lut = (LAS float*)(lds + ATT_LUT);
  for (int idx = blockIdx.x; idx < 2048; idx += gridDim.x) {
    int tb, L, head, qb; unit_map(idx, 16, tb, L, head, qb);
    t5_lut(lut, p->in[7], head, tid);
    const int q0w = qb * 256 + 32 * w;
    f32x16 O[2]; float lt;
    flash_pass<96, 64, 0>(lds, Q + (size_t)(tb + q0w) * 1536 + head * 96, 1536, Kf + (size_t)tb * 1536 + head * 96, 1536, Vt + (size_t)tb * DM, head * 64, 0, L, L / 64,
                          -q0w, lut, 0, 0, 0, 0, O, lt);
    const float inv = 1.f / lt;
    bf16_t* op = Oo + (size_t)(tb + q0w + r) * DM + head * 64 + 4 * hh;
#pragma unroll
    for (int db = 0; db < 2; ++db)
#pragma unroll
      for (int g = 0; g < 4; ++g) { f32x4 v; v[0] = O[db][4 * g] * inv; v[1] = O[db][4 * g + 1] * inv; v[2] = O[db][4 * g + 2] * inv; v[3] = O[db][4 * g + 3] * inv; *(u32x2*)(op + 32 * db + 8 * g) = pk4(v); }
  }
}

DI void att_diff_phase(KP p, int layer, LAS unsigned char* lds) {
  const int tid = opaque_tid(), w = tid >> 6, lane = tid & 63, r = lane & 31, hh = lane >> 5;
  const bf16_t* Q = (const bf16_t*)(p->ws + OFF_BIG); const bf16_t* Kd = (const bf16_t*)(p->ws + OFF_BIG + 64 * MiB);
  const bf16_t* Vt = (const bf16_t*)(p->ws + OFF_BIG + 128 * MiB); bf16_t* Oo = (bf16_t*)(p->ws + OFF_BIG + 192 * MiB);
  LAS float* lut = (LAS float*)(lds + ATT_LUT);
  float d1 = p->in[19][lane] * p->in[20][lane], d2 = p->in[21][lane] * p->in[22][lane];
#pragma unroll
  for (int o = 1; o < 64; o <<= 1) { d1 += __shfl_xor(d1, o); d2 += __shfl_xor(d2, o); }
  const float lam_init = 0.8f - 0.6f * expf(-0.3f * (float)layer);
  const float lam = expf(d1) - expf(d2) + lam_init;
  for (int idx = blockIdx.x; idx < 1024; idx += gridDim.x) {
    int tb, L, head, qb; unit_map(idx, 8, tb, L, head, qb);
    const int q0w = qb * 256 + 32 * w;
    f32x16 O0[4]; float lt0, lt1;
    t5_lut(lut, p->in[7], 2 * head, tid);
    flash_pass<64, 128, 0>(lds, Q + (size_t)(tb + q0w) * DM + (2 * head) * 64, DM, Kd + (size_t)tb * DM + (2 * head) * 64, DM, Vt + (size_t)tb * DM, head * 128, 0, L, L / 64,
                           -q0w, lut, 0, 0, 0, 0, O0, lt0);
    float* scr0 = (float*)(p->ws + OFF_A) + ((size_t)blockIdx.x * 512 + tid) * 64;
    { const float i0 = 1.f / lt0;
#pragma unroll
      for (int db = 0; db < 4; ++db)
#pragma unroll
        for (int i = 0; i < 16; i += 4) { f32x4 v; v[0] = O0[db][i] * i0; v[1] = O0[db][i + 1] * i0; v[2] = O0[db][i + 2] * i0; v[3] = O0[db][i + 3] * i0; *(f32x4*)(scr0 + db * 16 + i) = v; } }
    t5_lut(lut, p->in[7], 2 * head + 1, tid);
    flash_pass<64, 128, 0>(lds, Q + (size_t)(tb + q0w) * DM + (2 * head + 1) * 64, DM, Kd + (size_t)tb * DM + (2 * head + 1) * 64, DM, Vt + (size_t)tb * DM, head * 128, 0, L, L / 64,
                           -q0w, lut, 0, 0, 0, 0, O0, lt1);
    const float i1 = lam / lt1;
    const float* scr1 = scr0; asm volatile("" : "+v"(scr1));
    float ss = 0.f;
#pragma unroll
    for (int db = 0; db < 4; ++db)
#pragma unroll
      for (int i = 0; i < 16; i += 4) { const f32x4 v = *(const f32x4*)(scr1 + db * 16 + i);
#pragma unroll
        for (int e = 0; e < 4; ++e) { const float a = v[e] - O0[db][i + e] * i1; O0[db][i + e] = a; ss += a * a; } }
    ss += __shfl_xor(ss, 32);
    const float sc = rsqrtf(ss * (1.f / 128.f) + EPS) * (1.f - lam_init);
    bf16_t* op = Oo + (size_t)(tb + q0w + r) * DM + head * 128 + 4 * hh;
    const float* gs = p->in[23] + 4 * hh;
#pragma unroll
    for (int db = 0; db < 4; ++db)
#pragma unroll
      for (int g = 0; g < 4; ++g) { const f32x4 gv = *(const f32x4*)(gs + 32 * db + 8 * g); f32x4 v; v[0] = O0[db][4 * g] * sc * gv[0]; v[1] = O0[db][4 * g + 1] * sc * gv[1]; v[2] = O0[db][4 * g + 2] * sc * gv[2]; v[3] = O0[db][4 * g + 3] * sc * gv[3];
        *(u32x2*)(op + 32 * db + 8 * g) = pk4(v); }
  }
}

DI void att_na_phase(KP p, LAS unsigned char* lds) {
  const int tid = opaque_tid(), w = tid >> 6, lane = tid & 63, r = lane & 31, hh = lane >> 5;
  const bf16_t* Q = (const bf16_t*)(p->ws + OFF_BIG); const bf16_t* Kd = (const bf16_t*)(p->ws + OFF_BIG + 64 * MiB);
  const bf16_t* Vt = (const bf16_t*)(p->ws + OFF_BIG + 128 * MiB); bf16_t* Oo = (bf16_t*)(p->ws + OFF_BIG + 192 * MiB);
  LAS float* lut = (LAS float*)(lds + ATT_LUT);
  for (int idx = blockIdx.x; idx < 2048; idx += gridDim.x) {
    int tb, L, head, qb; unit_map(idx, 16, tb, L, head, qb);
    if (tid < 480) { const int rw = tid >> 5, cl = tid & 31; lut[tid] = cl < 31 ? p->in[26][head * 465 + rw * 31 + cl] * LOG2E : -1e30f; }
    const int rows = L / 64, R0 = 4 * qb, ri = R0 + (w >> 1), cw = 32 * (w & 1);
    int rs_w = ri - 4; rs_w = rs_w < 0 ? 0 : (rs_w > rows - 8 ? rows - 8 : rs_w);
    int ka_lo = R0 - 4; ka_lo = ka_lo < 0 ? 0 : (ka_lo > rows - 8 ? rows - 8 : ka_lo);
    int ka_hi = R0 - 1; ka_hi = (ka_hi < 0 ? 0 : (ka_hi > rows - 8 ? rows - 8 : ka_hi)) + 7;
    const int q0w = R0 * 64 + 32 * w;
    f32x16 O[2]; float lt;
    flash_pass<64, 64, 1>(lds, Q + (size_t)(tb + q0w) * DM + head * 64, DM, Kd + (size_t)(tb + ka_lo * 64) * DM + head * 64, DM, Vt + (size_t)tb * DM, head * 64, ka_lo * 64, L,
                          ka_hi - ka_lo + 1, 0, lut, ka_lo, ri, rs_w, cw, O, lt);
    const float inv = 1.f / lt;
    bf16_t* op = Oo + (size_t)(tb + q0w + r) * DM + head * 64 + 4 * hh;
#pragma unroll
    for (int db = 0; db < 2; ++db)
#pragma unroll
      for (int g = 0; g < 4; ++g) { f32x4 v; v[0] = O[db][4 * g] * inv; v[1] = O[db][4 * g + 1] * inv; v[2] = O[db][4 * g + 2] * inv; v[3] = O[db][4 * g + 3] * inv; *(u32x2*)(op + 32 * db + 8 * g) = pk4(v); }
  }
}

DI void final_phase(KP p) {
  const int tid = opaque_tid(), wid = tid >> 6, lane = tid & 63;
  const float* P4 = (const float*)(p->ws + OFF_P4); const float* fg = p->in[3]; const bf16_t* XR = (const bf16_t*)(p->ws + OFF_XR);
  for (int row = blockIdx.x * 8 + wid; row < T; row += gridDim.x * 8) {
    const float rs = row_rstd(P4, 4, 1.f / 1024.f, row);
#pragma unroll
    for (int q = 0; q < 4; ++q) {
      const u32x2 xw = *(const u32x2*)(XR + (size_t)row * DM + 256 * q + 4 * lane);
      f32x4 v; v[0] = __uint_as_float(xw.x << 16); v[1] = __uint_as_float(xw.x & 0xffff0000u); v[2] = __uint_as_float(xw.y << 16); v[3] = __uint_as_float(xw.y & 0xffff0000u);
      const f32x4 g = *(const f32x4*)(fg + 256 * q + 4 * lane);
      *(f32x4*)(p->out + (size_t)row * DM + 256 * q + 4 * lane) = v * rs * g;
    }
  }
}

#define XB_TMO      128
#define XB_XCNT(j)  (256  + 64 * (j))
#define XB_XSUB(j)  (1280 + 64 * (j))
#define XB_XGEN(j)  (2304 + 64 * (j))
#define XB_TOP      3328
#define XB_TOPGEN   3392
#define XCD_BAR_WORDS 3456
#define XB_SPIN_CAP (1u << 18)
DI unsigned xb_ld(unsigned* p)              { return __hip_atomic_load(p, __ATOMIC_RELAXED, __HIP_MEMORY_SCOPE_AGENT); }
DI unsigned xb_add(unsigned* p, unsigned v) { return __hip_atomic_fetch_add(p, v, __ATOMIC_RELAXED, __HIP_MEMORY_SCOPE_AGENT); }
DI unsigned xb_xcc_id() { return (unsigned)__builtin_amdgcn_s_getreg((3 << 11) | 20) & 0xFu; }
#define XB_SPIN(cond, bar) do { unsigned _sp = 0; while (cond) { __builtin_amdgcn_s_sleep(1); \
    if ((++_sp & 255u) == 0u) { if (xb_ld(&(bar)[XB_TMO])) break; if (_sp > XB_SPIN_CAP) { atomicAdd(&(bar)[XB_TMO], 1u); break; } } } } while (0)
struct XcdBarrier { unsigned* bar; unsigned x; volatile LAS unsigned* st; };
DI XcdBarrier xcd_barrier_post(unsigned* bar, volatile LAS unsigned* st) {
  XcdBarrier b; b.bar = bar; b.x = xb_xcc_id(); b.st = st;
  if (threadIdx.x == 0) (void)xb_add(&bar[XB_XCNT(b.x)], 1u);
  return b;
}
DI void xcd_barrier_complete(unsigned* bar, unsigned x, unsigned& nloc, unsigned& nx) {
  const unsigned G = gridDim.x * gridDim.y * gridDim.z;
  unsigned sum, cnt, mine, sp = 0u;
  for (;;) {
    sum = 0u; cnt = 0u; mine = 0u;
#pragma unroll
    for (unsigned j = 0; j < 16; ++j) { const unsigned c = xb_ld(&bar[XB_XCNT(j)]); sum += c; cnt += (c > 0u) ? 1u : 0u; mine = (j == x) ? c : mine; }
    if (sum == G) break;
    __builtin_amdgcn_s_sleep(1);
    if ((++sp & 255u) == 0u) { if (xb_ld(&bar[XB_TMO])) break; if (sp > XB_SPIN_CAP) { atomicAdd(&bar[XB_TMO], 1u); break; } }
  }
  nloc = mine > 0u ? mine : 1u; nx = cnt > 0u ? cnt : 1u;
}
DI void xcd_barrier(const XcdBarrier& b) {
  asm volatile("s_waitcnt vmcnt(0)" ::: "memory");
  __syncthreads();
  if (threadIdx.x == 0) {
    unsigned* bar = b.bar;
    __builtin_amdgcn_s_waitcnt(0);
    unsigned nloc = b.st[0], nx = b.st[1];
    if (nloc == 0u) { xcd_barrier_complete(bar, b.x, nloc, nx); b.st[0] = nloc; b.st[1] = nx; }
    const unsigned old = xb_add(&bar[XB_XSUB(b.x)], 1u);
    const unsigned gen = old / nloc;
    if (old + 1u == (gen + 1u) * nloc) {
      __builtin_amdgcn_fence(__ATOMIC_RELEASE, "agent");
      asm volatile("s_waitcnt vmcnt(0)" ::: "memory");
      const unsigned og = xb_add(&bar[XB_TOP], 1u);
      const unsigned tg = og / nx;
      if (og + 1u == (tg + 1u) * nx) xb_add(&bar[XB_TOPGEN], 1u);
      else XB_SPIN(xb_ld(&bar[XB_TOPGEN]) == tg, bar);
      __builtin_amdgcn_fence(__ATOMIC_ACQUIRE, "agent");
      xb_add(&bar[XB_XGEN(b.x)], 1u);
      asm volatile("s_waitcnt vmcnt(0)" ::: "memory");
    } else {
      XB_SPIN(xb_ld(&bar[XB_XGEN(b.x)]) == gen, bar);
      __builtin_amdgcn_fence(__ATOMIC_ACQUIRE, "agent");
      asm volatile("s_waitcnt vmcnt(0)" ::: "memory");
    }
  }
  __syncthreads();
}

__global__ void __launch_bounds__(512) mega(Params p_unused) {
  extern __shared__ __attribute__((aligned(16))) unsigned char smem[];
  LAS unsigned char* lds = (LAS unsigned char*)smem;
  cg::grid_group grid = cg::this_grid();
  volatile LAS unsigned* xst = (volatile LAS unsigned*)(lds + 137216);
  if (threadIdx.x == 0) { xst[0] = 0u; xst[1] = 0u; }
  __syncthreads();
  const XcdBarrier xb = xcd_barrier_post(((KP)__builtin_amdgcn_kernarg_segment_ptr())->bar, xst);
  for (int pc = 0; pc < 48; ++pc) {
    KP p = (KP)__builtin_amdgcn_kernarg_segment_ptr(); asm volatile("" : "+s"(p));
    unsigned char* ws = p->ws;
    bf16_t* XB = (bf16_t*)(ws + OFF_XR);
    bf16_t* VTA = (bf16_t*)(ws + OFF_A);
    float* P4 = (float*)(ws + OFF_P4); float* PQ = (float*)(ws + OFF_PQ); float* PKV = (float*)(ws + OFF_PKV);
    const float* rope = (const float*)(ws + OFF_ROPE);
    bf16_t* BIG = (bf16_t*)(ws + OFF_BIG);
    bf16_t* WM = (bf16_t*)(ws + OFF_W + W_MIX);
    const unsigned op = PROG[pc]; const int kind = op & 15, layer = (op >> 4) & 3, sub = (op >> 6) & 1, sync = (op >> 7) & 1;
    if (kind == OP_END) break;
    if (kind == OP_CONV) {
#ifndef NO_CONV
      conv_phase(p, layer, lds);
#endif
    } else if (kind == OP_ATT_MLA) {
#ifndef NO_MLA
      att_mla_phase(p, lds);
#endif
    } else if (kind == OP_ATT_DIFF) {
#ifndef NO_DIFF
      att_diff_phase(p, layer, lds);
#endif
    } else if (kind == OP_ATT_NA) {
#ifndef NO_NA
      att_na_phase(p, lds);
#endif
    } else if (kind == OP_FINAL) final_phase(p);
    else {
#ifndef NO_GEMM
      GemmDesc d; d.nM = T / 256; d.vpn = 1 << 30; d.P = P4; d.np = 4; d.inv_dim = 1.f / 1024.f; d.O0 = nullptr; d.O1 = nullptr; d.O2 = nullptr; d.Pout = P4; d.Pout2 = PKV; d.rope = rope; d.kmode = 0; d.perm = 1; d.ablk = 0;
      const int mx = layer % 3;
      if (kind == OP_FFN_UP) { d.A = XB; d.lda = DM; d.B = (const bf16_t*)(ws + OFF_W + (sub ? W_GU1 : W_GU0)); d.ldb = DM; d.K = DM; d.nN = 22; d.epi = EPI_FFN_UP; d.O0 = BIG; }
      else if (kind == OP_FFN_DOWN) { d.A = BIG; d.lda = FF; d.B = (const bf16_t*)(ws + OFF_W + (sub ? W_DN1 : W_DN0)); d.ldb = FF; d.K = FF; d.nN = 4; d.epi = EPI_RESID; d.O0 = XB; d.ablk = 1; }
      else if (kind == OP_MLA_C) { d.A = XB; d.lda = DM; d.B = WM; d.ldb = DM; d.K = DM; d.nN = 4; d.epi = EPI_MLA_C; d.O0 = BIG; d.O1 = BIG + 80ull * MiB; d.Pout = PQ; d.Pout2 = PKV; }
      else if (kind == OP_MLA_Q) { d.A = BIG; d.lda = DM; d.B = WM + 1024 * 1024; d.ldb = 512; d.K = 512; d.nN = 6; d.epi = EPI_MLA_Q; d.P = PQ; d.np = 2; d.inv_dim = 1.f / 512.f; d.O0 = BIG + 32ull * MiB; }
      else if (kind == OP_MLA_KV) { d.A = BIG + 512; d.lda = DM; d.B = WM + 1024 * 1024 + 1536 * 512; d.ldb = 256; d.K = 256; d.nN = 8; d.vpn = 4; d.epi = EPI_KV; d.P = PKV; d.np = 1; d.inv_dim = 1.f / 256.f; d.kmode = 0; d.O0 = BIG + 80ull * MiB; d.O2 = VTA; }
      else if (kind == OP_QKV) { d.A = XB; d.lda = DM; d.B = WM; d.ldb = DM; d.K = DM; d.nN = 12; d.vpn = 8; d.epi = EPI_KV; d.kmode = 1; d.O0 = BIG; d.O1 = BIG + 32ull * MiB; d.O2 = BIG + 64ull * MiB; }
      else {   d.lda = DM; d.ldb = DM; d.K = DM; d.nN = 4; d.epi = EPI_RESID; d.O0 = XB;
        if (mx == 0) { d.A = BIG; d.B = WM + 1024 * 1024 + 1536 * 512 + 2048 * 256; } else { d.A = BIG + 96ull * MiB; d.B = WM + 3072 * 1024; } }
      const int nparts = d.vpn < d.nN ? 2 : 1;
      _Pragma("nounroll") for (int part = 0; part < nparts; ++part) {
        d.pn0 = part ? d.vpn : 0; d.nNs = part ? d.nN - d.vpn : (d.vpn < d.nN ? d.vpn : d.nN); d.swp = part;
        gemm_phase(lds, d, p->out);
      }
#endif
    }
    if (sync) { if (pc == 0) grid.sync(); else xcd_barrier(xb); }
  }
}

extern "C" void kernel_launch(void* const* d_in, const int* in_sizes, int n_in, void* d_out, int out_size, void* d_ws, size_t ws_size, hipStream_t stream) {
  static int grid_blocks = 0;
  constexpr int LDS_BYTES = 131072 + 2048 + 4096 + 16;
  if (grid_blocks == 0) {
    if (n_in != 28 || out_size != T * DM || ws_size < WS_END) { fprintf(stderr, "kernel_launch: unexpected shapes (n_in %d out %d ws %zu need %zu)\n", n_in, out_size, ws_size, (size_t)WS_END); grid_blocks = -1; return; }
    int dev = 0, cus = 0, per_cu = 0;
    hipGetDevice(&dev); hipDeviceGetAttribute(&cus, hipDeviceAttributeMultiprocessorCount, dev);
    if (hipFuncSetAttribute((const void*)mega, hipFuncAttributeMaxDynamicSharedMemorySize, LDS_BYTES) != hipSuccess) { fprintf(stderr, "hipFuncSetAttribute failed\n"); grid_blocks = -1; return; }
    hipOccupancyMaxActiveBlocksPerMultiprocessor(&per_cu, (const void*)mega, 512, LDS_BYTES);
    if (per_cu < 1) per_cu = 1;
    if (per_cu > 1) per_cu = 1;
    grid_blocks = cus * per_cu;
  }
  if (grid_blocks < 0) return;
  Params p{};
  for (int i = 0; i < 28; ++i) p.in[i] = (const float*)d_in[i];
  p.out = (float*)d_out; p.ws = (unsigned char*)d_ws; p.bar = (unsigned*)((unsigned char*)d_ws + OFF_XBAR);
  if (hipMemsetAsync(p.bar, 0, XCD_BAR_WORDS * sizeof(unsigned), stream) != hipSuccess) { fprintf(stderr, "barrier memset failed\n"); return; }
  void* args[] = {&p};
  hipError_t e = hipLaunchCooperativeKernel((const void*)mega, dim3(grid_blocks), dim3(512), args, LDS_BYTES, stream);
  if (e != hipSuccess) fprintf(stderr, "cooperative launch failed: %s (grid %d)\n", hipGetErrorString(e), grid_blocks);
}
```
